# Optimizing an MI355X kernel written in HIP

```python
import jax, jax.numpy as jnp
from jax import lax
import numpy as np

D_MODEL = 1024
BATCH = 8
SEQ = 4096
DEPTH = 2

GRID_W = 64
CTX_LEN = 256
CONV_W = 1024
CONV_K = 3
N_HEADS = 8
N_KV_HEADS = 2
HEAD_DIM = 128
GROUP = N_HEADS // N_KV_HEADS
Q_BLOCK = 128
ROPE_THETA = 10000.0
ROPE_AXIS_DIM = HEAD_DIM // 2
ROPE_PAIRS = ROPE_AXIS_DIM // 2
ATTN_SCALE = HEAD_DIM ** -0.5
GLA_HEADS = 4
GLA_DK = D_MODEL // 2
GLA_DV = D_MODEL
GLA_DKH = GLA_DK // GLA_HEADS
GLA_DVH = GLA_DV // GLA_HEADS
GLA_RANK = 16
GLA_TAU = 16.0
GLA_CHUNK = 64
N_BRANCH = 3
EPS = 1e-6

IN_SPLITS = (CONV_W, CONV_W, CONV_W, CONV_W,
             N_HEADS * HEAD_DIM, N_KV_HEADS * HEAD_DIM, N_KV_HEADS * HEAD_DIM,
             N_HEADS * HEAD_DIM,
             GLA_DK, GLA_DK, GLA_DV, GLA_RANK, GLA_RANK, GLA_DV,
             N_BRANCH * D_MODEL)
IN_WIDTH = sum(IN_SPLITS)

kernel_name = "hybrid_conv_gqa_gla_prefix_dit"


def _rmsnorm(x, g):
    xf = x.astype(jnp.float32)
    y = xf * lax.rsqrt(jnp.mean(xf * xf, axis=-1, keepdims=True) + EPS)
    return (y * g.astype(jnp.float32)).astype(x.dtype)


def _split_proj(p):
    offsets = np.cumsum(IN_SPLITS)[:-1].tolist()
    return jnp.split(p, offsets, axis=-1)


def _short_conv(u, w):
    up = jnp.pad(u, ((0, 0), (1, 1), (0, 0)))
    return w[0] * up[:, :-2] + w[1] * up[:, 1:-1] + w[2] * up[:, 2:]


def _axial_rope_tables(n_tokens):
    n_rows = n_tokens // GRID_W
    row = jnp.repeat(jnp.arange(n_rows, dtype=jnp.float32), GRID_W)
    col = jnp.tile(jnp.arange(GRID_W, dtype=jnp.float32), n_rows)
    freqs = ROPE_THETA ** (-jnp.arange(ROPE_PAIRS, dtype=jnp.float32) * 2.0 / ROPE_AXIS_DIM)
    ang = jnp.stack([row[:, None] * freqs, col[:, None] * freqs], axis=1)
    return jnp.cos(ang), jnp.sin(ang)


def _apply_rope(x, cos, sin):
    b_, t_, h_, _ = x.shape
    xr = x.reshape(b_, t_, h_, 2, 2, ROPE_PAIRS)
    x1, x2 = xr[..., 0, :], xr[..., 1, :]
    c_, s_ = cos[None, :, None], sin[None, :, None]
    out = jnp.stack([x1 * c_ - x2 * s_, x2 * c_ + x1 * s_], axis=-2)
    return out.reshape(b_, t_, h_, HEAD_DIM).astype(x.dtype)


def _attn_heads(q, k, v, q_g, k_g, rope):
    b_, t_ = q.shape[:2]
    q = _rmsnorm(q.reshape(b_, t_, N_HEADS, HEAD_DIM), q_g)
    k = _rmsnorm(k.reshape(b_, t_, N_KV_HEADS, HEAD_DIM), k_g)
    v = v.reshape(b_, t_, N_KV_HEADS, HEAD_DIM)
    if rope is not None:
        q = _apply_rope(q, *rope)
        k = _apply_rope(k, *rope)
    return q, k, v


def _sdpa_blocks(q, keys, vals):
    b_, t_ = q.shape[:2]
    nb = t_ // Q_BLOCK
    qb = q.reshape(b_, nb, Q_BLOCK, N_KV_HEADS, GROUP, HEAD_DIM).transpose(1, 0, 2, 3, 4, 5)

    def one_block(qblk):
        s = jnp.einsum('bqkgd,bskd->bkgqs', qblk, keys).astype(jnp.float32) * ATTN_SCALE
        p = jax.nn.softmax(s, axis=-1).astype(vals.dtype)
        return jnp.einsum('bkgqs,bskd->bqkgd', p, vals)

    o = lax.map(one_block, qb)
    return o.transpose(1, 0, 2, 3, 4, 5).reshape(b_, t_, N_HEADS * HEAD_DIM)


def _gla_inputs(q, k, v, r_f, r_b, w_df, b_df, w_db, b_db):
    b_, t_ = q.shape[:2]
    q = q.reshape(b_, t_, GLA_HEADS, GLA_DKH) * (GLA_DKH ** -0.5)
    k = k.reshape(b_, t_, GLA_HEADS, GLA_DKH)
    v = v.reshape(b_, t_, GLA_HEADS, GLA_DVH)
    la_f = (jax.nn.log_sigmoid((r_f @ w_df + b_df).astype(jnp.float32)) / GLA_TAU).reshape(b_, t_, GLA_HEADS, GLA_DKH)
    la_b = (jax.nn.log_sigmoid((r_b @ w_db + b_db).astype(jnp.float32)) / GLA_TAU).reshape(b_, t_, GLA_HEADS, GLA_DKH)
    return q, k, v, la_f, la_b


def _gla_scan(q, k, v, log_a, s0):
    b_, t_, h_, _ = q.shape
    dv = v.shape[-1]
    nc = t_ // GLA_CHUNK

    def chunks(a):
        return a.astype(jnp.float32).reshape(b_, nc, GLA_CHUNK, h_, a.shape[-1]).transpose(1, 0, 3, 2, 4)

    mask = jnp.tril(jnp.ones((GLA_CHUNK, GLA_CHUNK), dtype=bool))

    def step(s, inp):
        qc, kc, vc, ac = inp
        bcum = jnp.cumsum(ac, axis=2)
        o_inter = jnp.einsum('bhtd,bhde->bhte', qc * jnp.exp(bcum), s)
        diff = bcum[:, :, :, None, :] - bcum[:, :, None, :, :]
        decay = jnp.exp(jnp.where(mask[:, :, None], diff, -jnp.inf))
        att = jnp.einsum('bhtd,bhsd,bhtsd->bhts', qc, kc, decay)
        o_intra = jnp.einsum('bhts,bhse->bhte', att, vc)
        b_last = bcum[:, :, -1:, :]
        s_new = jnp.exp(b_last[:, :, 0, :])[..., None] * s + jnp.einsum('bhsd,bhse->bhde', kc * jnp.exp(b_last - bcum), vc)
        return s_new, o_inter + o_intra

    s_f, o = lax.scan(step, s0, (chunks(q), chunks(k), chunks(v), chunks(log_a)))
    o = o.transpose(1, 0, 3, 2, 4).reshape(b_, t_, h_, dv)
    return o.astype(v.dtype), s_f


def _flip(a):
    return jnp.flip(a, axis=1)


def _gla_bidirectional(ctx_in, lat_in):
    qc, kc, vc, lfc, lbc = ctx_in
    ql, kl, vl, lfl, lbl = lat_in
    s0 = jnp.zeros((qc.shape[0], GLA_HEADS, GLA_DKH, GLA_DVH), jnp.float32)
    o_cf, s_f = _gla_scan(qc, kc, vc, lfc, s0)
    o_cb, s_b = _gla_scan(_flip(qc), _flip(kc), _flip(vc), _flip(lbc), s0)
    o_lf, _ = _gla_scan(ql, kl, vl, lfl, s_f)
    o_lb, _ = _gla_scan(_flip(ql), _flip(kl), _flip(vl), _flip(lbl), s_b)
    return o_lf + _flip(o_lb), o_cf + _flip(o_cb)


def _mixer_output(parts, att_o, gla_o, conv_w_l, gla_g_l, w_br_conv_l, w_br_attn_l, w_br_gla_l, b_gate_l, w_out_l):
    a_b, a_c, a_x, a_z = parts[0], parts[1], parts[2], parts[3]
    z_attn, z_gla, mg = parts[7], parts[13], parts[14]
    b_, t_ = a_b.shape[:2]
    br_a = ((a_b * _short_conv(a_c * a_x, conv_w_l)) * jax.nn.silu(a_z)) @ w_br_conv_l
    br_b = (att_o * jax.nn.silu(z_attn)) @ w_br_attn_l
    br_c = (_rmsnorm(gla_o, gla_g_l).reshape(b_, t_, GLA_DV) * jax.nn.silu(z_gla)) @ w_br_gla_l
    g_a, g_b, g_c = jnp.split(jax.nn.sigmoid(mg + b_gate_l), N_BRANCH, axis=-1)
    return (g_a * br_a + g_b * br_b + g_c * br_c) @ w_out_l


def setup_inputs(seed: int = 0) -> dict:
    key = jax.random.key(seed)
    ks = jax.random.split(key, 24)
    n = jax.random.normal
    f32 = jnp.float32
    return {
        "x": n(ks[0], (BATCH, SEQ, D_MODEL), f32),
        "c": n(ks[1], (BATCH, D_MODEL), f32),
        "ctx": n(ks[2], (BATCH, CTX_LEN, D_MODEL), f32),
        "c_ctx": n(ks[3], (D_MODEL,), f32),
        "w_ada": n(ks[4], (DEPTH, D_MODEL, 3 * D_MODEL), f32) * D_MODEL ** -0.5,
        "b_ada": 0.02 * n(ks[5], (DEPTH, 3 * D_MODEL), f32),
        "g_pre": 1.0 + 0.02 * n(ks[6], (DEPTH, D_MODEL), f32),
        "g_post": 1.0 + 0.02 * n(ks[7], (DEPTH, D_MODEL), f32),
        "w_in": n(ks[8], (DEPTH, D_MODEL, IN_WIDTH), f32) * D_MODEL ** -0.5,
        "conv_w": n(ks[9], (DEPTH, CONV_K, CONV_W), f32) * CONV_K ** -0.5,
        "q_norm_g": 1.0 + 0.02 * n(ks[10], (DEPTH, HEAD_DIM), f32),
        "k_norm_g": 1.0 + 0.02 * n(ks[11], (DEPTH, HEAD_DIM), f32),
        "w_decay_fwd": n(ks[12], (DEPTH, GLA_RANK, GLA_DK), f32) * GLA_RANK ** -0.5,
        "b_decay_fwd": 0.01 * n(ks[13], (DEPTH, GLA_DK), f32),
        "w_decay_bwd": n(ks[14], (DEPTH, GLA_RANK, GLA_DK), f32) * GLA_RANK ** -0.5,
        "b_decay_bwd": 0.01 * n(ks[15], (DEPTH, GLA_DK), f32),
        "gla_norm_g": 1.0 + 0.02 * n(ks[16], (DEPTH, GLA_DVH), f32),
        "w_br_conv": n(ks[17], (DEPTH, CONV_W, D_MODEL), f32) * CONV_W ** -0.5,
        "w_br_attn": n(ks[18], (DEPTH, N_HEADS * HEAD_DIM, D_MODEL), f32) * (N_HEADS * HEAD_DIM) ** -0.5,
        "w_br_gla": n(ks[19], (DEPTH, GLA_DV, D_MODEL), f32) * GLA_DV ** -0.5,
        "b_gate": 0.02 * n(ks[20], (DEPTH, N_BRANCH * D_MODEL), f32),
        "w_out": n(ks[21], (DEPTH, D_MODEL, D_MODEL), f32) * D_MODEL ** -0.5,
    }


def reference(x, c, ctx, c_ctx, w_ada, b_ada, g_pre, g_post, w_in, conv_w, q_norm_g, k_norm_g,
              w_decay_fwd, b_decay_fwd, w_decay_bwd, b_decay_bwd, gla_norm_g,
              w_br_conv, w_br_attn, w_br_gla, b_gate, w_out):
    n_tok = x.shape[1]
    rope = _axial_rope_tables(n_tok)
    xc = ctx
    for l in range(DEPTH):
        last = l == DEPTH - 1
        mod_l = jax.nn.silu(c) @ w_ada[l] + b_ada[l]
        sh_l, sc_l, gt_l = jnp.split(mod_l[:, None, :], 3, axis=-1)
        mod_c = jax.nn.silu(c_ctx) @ w_ada[l] + b_ada[l]
        sh_c, sc_c, gt_c = jnp.split(mod_c, 3, axis=-1)
        h_l = _rmsnorm(x, g_pre[l]) * (1.0 + sc_l) + sh_l
        h_c = _rmsnorm(xc, g_pre[l]) * (1.0 + sc_c) + sh_c
        pl = _split_proj(h_l @ w_in[l])
        pc = _split_proj(h_c @ w_in[l])
        q_l, k_l, v_l = _attn_heads(pl[4], pl[5], pl[6], q_norm_g[l], k_norm_g[l], rope)
        q_c, k_c, v_c = _attn_heads(pc[4], pc[5], pc[6], q_norm_g[l], k_norm_g[l], None)
        keys = jnp.concatenate([k_l, k_c], axis=1)
        vals = jnp.concatenate([v_l, v_c], axis=1)
        att_l = _sdpa_blocks(q_l, keys, vals)
        dec = (w_decay_fwd[l], b_decay_fwd[l], w_decay_bwd[l], b_decay_bwd[l])
        gla_c_in = _gla_inputs(pc[8], pc[9], pc[10], pc[11], pc[12], *dec)
        gla_l_in = _gla_inputs(pl[8], pl[9], pl[10], pl[11], pl[12], *dec)
        gla_l, gla_c = _gla_bidirectional(gla_c_in, gla_l_in)
        shared = (conv_w[l], gla_norm_g[l], w_br_conv[l], w_br_attn[l], w_br_gla[l], b_gate[l], w_out[l])
        out_l = _mixer_output(pl, att_l, gla_l, *shared)
        if not last:
            att_c = _sdpa_blocks(q_c, k_c, v_c)
            out_c = _mixer_output(pc, att_c, gla_c, *shared)
            xc = xc + gt_c * _rmsnorm(out_c, g_post[l])
        x = x + gt_l * _rmsnorm(out_l, g_post[l])
    return x
```

```cpp
#include <hip/hip_runtime.h>
#include <hip/hip_bf16.h>
#include <hip/hip_cooperative_groups.h>
#include <cstdio>
#include <cstdint>
namespace cg = cooperative_groups;

typedef unsigned short bf16_t;
using bf16x8 = __attribute__((ext_vector_type(8))) short;
using s16x4  = __attribute__((ext_vector_type(4))) short;
using f32x4  = __attribute__((ext_vector_type(4))) float;
using f32x16 = __attribute__((ext_vector_type(16))) float;
using u32x4  = __attribute__((ext_vector_type(4))) unsigned;
using u32x2  = __attribute__((ext_vector_type(2))) unsigned;

constexpr int DM = 1024, NB = 8, SEQ = 4096, CTXL = 256, INW = 12832;
constexpr int GROWS = 8704;
constexpr int NLAT = 8192;
constexpr int NPAD = 13056;
constexpr int LDP = 10752;
constexpr int PC_CX = 0, PC_BZ = 1024, PC_Q = 2048, PC_K = 3072, PC_V = 3328, PC_ZA = 3584, PC_GQ = 4608, PC_GK = 5120,
              PC_GV = 5632, PC_ZG = 6656, PC_MG = 7680;
constexpr int SKV = 4352;
constexpr float EPS = 1e-6f;

constexpr size_t al256(size_t x) { return (x + 255) / 256 * 256; }
constexpr size_t WS_WTIN = 0;
constexpr size_t WS_WTBR = WS_WTIN + al256((size_t)2 * NPAD * 1024 * 2);
constexpr size_t WS_WTOUT = WS_WTBR + al256((size_t)2 * 3 * 1024 * 1024 * 2);
constexpr size_t WS_MOD = WS_WTOUT + al256((size_t)2 * 1024 * 1024 * 2);
constexpr size_t WS_H = WS_MOD + al256((size_t)2 * 9 * 3072 * 4);
constexpr size_t WS_PROJ = WS_H + al256((size_t)GROWS * 1024 * 2);
constexpr size_t WS_R = WS_PROJ + al256((size_t)GROWS * LDP * 2);
constexpr size_t WS_KBUF = WS_R + al256((size_t)GROWS * 32 * 4);
constexpr size_t WS_VBUF = WS_KBUF + al256((size_t)4 * SKV * 128 * 2);
constexpr size_t WS_QT = WS_VBUF + al256((size_t)4 * SKV * 128 * 2);
constexpr size_t WS_KT = WS_QT + al256((size_t)2 * GROWS * 512 * 2);
constexpr size_t WS_KTT = WS_KT + al256((size_t)2 * GROWS * 512 * 2);
constexpr size_t WS_VT = WS_KTT + al256((size_t)2 * GROWS * 512 * 2);
constexpr size_t WS_E = WS_VT + al256((size_t)1024 * GROWS * 2);
constexpr size_t WS_OG = WS_E + al256((size_t)2 * 136 * 512 * 4);
constexpr size_t WS_UA = WS_OG + al256((size_t)2 * GROWS * 1024 * 2);
constexpr size_t WS_UB = WS_UA + al256((size_t)GROWS * 1024 * 2);
constexpr size_t WS_UC = WS_UB + al256((size_t)GROWS * 1024 * 2);
constexpr size_t WS_M = WS_UC + al256((size_t)GROWS * 1024 * 2);
constexpr size_t WS_OUTF = WS_M + al256((size_t)GROWS * 1024 * 2);
constexpr size_t WS_MF = WS_OUTF;
constexpr size_t WS_BAR = WS_OUTF + al256((size_t)GROWS * 1024 * 4);
constexpr size_t WS_END = WS_BAR + 16384;
static_assert(WS_END <= (size_t)512 * 1024 * 1024, "workspace must fit 512 MiB");

struct Params {
  const float *x, *c, *ctx, *c_ctx, *w_ada, *b_ada, *g_pre, *g_post, *w_in, *conv_w, *q_g, *k_g, *w_df, *b_df, *w_db, *b_db,
      *gla_g, *w_bc, *w_ba, *w_bg, *b_gate, *w_out;
  float* out;
  char* ws;
};

extern __shared__ __attribute__((aligned(16))) char smem[];
constexpr int SMEM_MAIN = 151552;
constexpr int SMEM_BYTES = SMEM_MAIN + 256;

typedef __bf16 bf16v2_t __attribute__((ext_vector_type(2)));
typedef float f32v2_t __attribute__((ext_vector_type(2)));
__device__ __forceinline__ unsigned cvtpk(float lo, float hi) {
  f32v2_t f = {lo, hi};
  bf16v2_t b = __builtin_convertvector(f, bf16v2_t);
  return __builtin_bit_cast(unsigned, b);
}
__device__ __forceinline__ bf16_t f2bf(float x) { return (bf16_t)(cvtpk(x, 0.f) & 0xffffu); }
__device__ __forceinline__ float bf2f(bf16_t b) { return __uint_as_float(((unsigned)b) << 16); }
__device__ __forceinline__ float bflo(unsigned w) { return __uint_as_float(w << 16); }
__device__ __forceinline__ float bfhi(unsigned w) { return __uint_as_float(w & 0xffff0000u); }
__device__ __forceinline__ float wave_sum(float v) {
#pragma unroll
  for (int o = 32; o >= 1; o >>= 1) v += __shfl_xor(v, o, 64);
  return v;
}
__device__ __forceinline__ float silu_f(float x) { return x * __builtin_amdgcn_rcpf(1.f + __expf(-x)); }
__device__ __forceinline__ float sigmoid_f(float x) { return __builtin_amdgcn_rcpf(1.f + __expf(-x)); }

constexpr int BM = 256, BK = 64, HALF = 128, NXCD = 8, WGM = 8, HT = HALF * BK;
__device__ __forceinline__ int lds_byte(int r, int c) {
  int st = (r >> 4) * 2 + (c >> 5), rr = r & 15, cc = c & 31, ob = rr * 64 + cc * 2;
  return st * 1024 + (ob ^ (((ob >> 9) & 1) << 5));
}
__device__ __forceinline__ void stage_rc(int b, int& R, int& C) {
  int st = b / 1024, sb = b % 1024, swz = sb ^ (((sb >> 9) & 1) << 5);
  R = (st >> 1) * 16 + swz / 64; C = (st & 1) * 32 + (swz % 64) / 2;
}
__device__ __forceinline__ bool tile_of(int L, int nM, int nN, int& pm, int& pn) {
  const int nwg = nM * nN; if (L >= nwg) return false;
  int wgid = L; { const int q = nwg / NXCD, r = nwg % NXCD, xcd = wgid % NXCD, off = wgid / NXCD; wgid = (xcd < r ? xcd * (q + 1) : r * (q + 1) + (xcd - r) * q) + off; }
  const int nig = WGM * nN, gid = wgid / nig, fm = gid * WGM, gsz = (nM - fm) < WGM ? (nM - fm) : WGM;
  pm = fm + ((wgid % nig) % gsz); pn = (wgid % nig) / gsz; return true;
}

#define LAS __attribute__((address_space(3)))
constexpr int HTB = HALF * BK * 2;
template <class Epi, bool PERMB = false>
__device__ __forceinline__ void gemm_tile(const bf16_t* __restrict__ A, const bf16_t* __restrict__ Bt, const int K, const int brow,
                                          const int bcol, const Epi& epi) {
  LAS unsigned char* lds = (LAS unsigned char*)smem;
  int tid = threadIdx.x; asm volatile("" : "+v"(tid));
  const int wid = __builtin_amdgcn_readfirstlane(tid >> 6), lane = tid & 63, wr = wid >> 2, wc = wid & 3, fr = lane & 15, fq = lane >> 4;
  unsigned voff[2], voffb[2];
#pragma unroll
  for (int i = 0; i < 2; ++i) { int R, C; stage_rc(tid * 16 + i * 8192, R, C); voff[i] = (unsigned)(R * K + C) * 2u;
    const int rho = R & 31, ii = rho & 15, Rb = PERMB ? ((R & ~31) + 8 * (ii >> 2) + 4 * (rho >> 4) + (ii & 3)) : R;
    voffb[i] = (unsigned)(Rb * K + C) * 2u; }
  const size_t kstep = (size_t)(BK * 2), hstep = (size_t)HALF * K * 2;
  const unsigned ldsw = (unsigned)wid * 1024u;
  const int aoff = lds_byte(wr * 64 + fr, fq * 8), boff = lds_byte(wc * 32 + fr, fq * 8);
  const char* cA = (const char*)A + (size_t)brow * K * 2; const char* cB = (const char*)Bt + (size_t)bcol * K * 2;
#define SA(b, h) (((b) * 2 + (h)) * HTB)
#define SB(b, h) ((4 + (b) * 2 + (h)) * HTB)
#define STAGE(bufoff, gbase) do { _Pragma("unroll") for (int _i = 0; _i < 2; ++_i) \
    __builtin_amdgcn_global_load_lds((const unsigned*)((const char*)(gbase) + voff[_i]), (LAS unsigned*)(lds + (bufoff) + ldsw + _i * 8192), 16, 0, 0); } while (0)
#define STAGEB(bufoff, gbase) do { _Pragma("unroll") for (int _i = 0; _i < 2; ++_i) \
    __builtin_amdgcn_global_load_lds((const unsigned*)((const char*)(gbase) + voffb[_i]), (LAS unsigned*)(lds + (bufoff) + ldsw + _i * 8192), 16, 0, 0); } while (0)
#define LDA(dst, b, h) do { _Pragma("unroll") for (int m = 0; m < 4; ++m) _Pragma("unroll") for (int k = 0; k < 2; ++k) dst[m][k] = *(const LAS bf16x8*)(lds + SA(b, h) + aoff + m * 2048 + k * 1024); } while (0)
#define LDB(dst, b, h) do { _Pragma("unroll") for (int n = 0; n < 2; ++n) _Pragma("unroll") for (int k = 0; k < 2; ++k) dst[n][k] = *(const LAS bf16x8*)(lds + SB(b, h) + boff + n * 2048 + k * 1024); } while (0)
#define MMA(ai, bj, At_, Bt_) do { __builtin_amdgcn_s_setprio(1); _Pragma("unroll") for (int m = 0; m < 4; ++m) _Pragma("unroll") for (int n = 0; n < 2; ++n) _Pragma("unroll") for (int k = 0; k < 2; ++k) \
      acc[ai][bj][m][n] = __builtin_amdgcn_mfma_f32_16x16x32_bf16(Bt_[n][k], At_[m][k], acc[ai][bj][m][n], 0, 0, 0); \
    __builtin_amdgcn_s_setprio(0); } while (0)
#define WAIT_V(n) asm volatile("s_waitcnt vmcnt(" #n ")" ::: "memory")
#define WAIT_L(n) asm volatile("s_waitcnt lgkmcnt(" #n ")" ::: "memory")
#define BAR __builtin_amdgcn_s_barrier()
#define SCHED __builtin_amdgcn_sched_barrier(0)
  f32x4 acc[2][2][4][2];
#pragma unroll
  for (int a = 0; a < 2; ++a)
#pragma unroll
    for (int b = 0; b < 2; ++b)
#pragma unroll
      for (int m = 0; m < 4; ++m)
#pragma unroll
        for (int n = 0; n < 2; ++n) acc[a][b][m][n] = (f32x4){0.f, 0.f, 0.f, 0.f};
  bf16x8 At[4][2], B0[2][2], B1[2][2];
  const int nt = K / BK;
  STAGEB(SB(0, 0), cB); STAGE(SA(0, 0), cA); STAGEB(SB(0, 1), cB + hstep); STAGE(SA(0, 1), cA + hstep);
  if (wr == 1) BAR;
  WAIT_V(4); BAR;
  STAGEB(SB(1, 0), cB + kstep); STAGE(SA(1, 0), cA + kstep); STAGEB(SB(1, 1), cB + hstep + kstep);
  WAIT_V(6); BAR;
  for (int t = 0; t < nt - 2; t += 2) {
    const char* a1 = cA + (size_t)(t + 1) * kstep; const char* a2 = a1 + kstep; const char* a3 = a2 + kstep;
    const char* b2 = cB + (size_t)(t + 2) * kstep; const char* b3 = b2 + kstep;
    LDB(B0, 0, 0); SCHED; LDA(At, 0, 0); STAGE(SA(1, 1), a1 + hstep);
    WAIT_L(8); BAR; WAIT_L(0); MMA(0, 0, At, B0); BAR; SCHED;
    LDB(B1, 0, 1); STAGEB(SB(0, 0), b2);
    BAR; WAIT_L(0); MMA(0, 1, At, B1); BAR;
    LDA(At, 0, 1); STAGE(SA(0, 0), a2);
    BAR; WAIT_L(0); MMA(1, 0, At, B0); BAR; SCHED;
    STAGEB(SB(0, 1), b2 + hstep);
    WAIT_V(6); BAR; MMA(1, 1, At, B1); BAR;
    LDB(B0, 1, 0); SCHED; LDA(At, 1, 0); STAGE(SA(0, 1), a2 + hstep);
    WAIT_L(8); BAR; WAIT_L(0); MMA(0, 0, At, B0); BAR; SCHED;
    LDB(B1, 1, 1); STAGEB(SB(1, 0), b3);
    BAR; WAIT_L(0); MMA(0, 1, At, B1); BAR;
    LDA(At, 1, 1); STAGE(SA(1, 0), a3);
    BAR; WAIT_L(0); MMA(1, 0, At, B0); BAR; SCHED;
    STAGEB(SB(1, 1), b3 + hstep);
    WAIT_V(6); BAR; MMA(1, 1, At, B1); BAR;
  }
  { LDB(B0, 0, 0); LDA(At, 0, 0); STAGE(SA(1, 1), cA + (size_t)(nt - 1) * kstep + hstep);
    BAR; WAIT_L(0); MMA(0, 0, At, B0); BAR;
    LDB(B1, 0, 1); BAR; WAIT_L(0); MMA(0, 1, At, B1); BAR;
    LDA(At, 0, 1); WAIT_V(4); BAR; WAIT_L(0); MMA(1, 0, At, B0); MMA(1, 1, At, B1); BAR; }
  { LDB(B0, 1, 0); LDA(At, 1, 0); WAIT_V(2); BAR; WAIT_L(0); MMA(0, 0, At, B0); BAR;
    LDB(B1, 1, 1); WAIT_V(0); BAR; WAIT_L(0); MMA(0, 1, At, B1); BAR;
    LDA(At, 1, 1); BAR; WAIT_L(0); MMA(1, 0, At, B0); MMA(1, 1, At, B1); BAR; }
  if (wr == 0) BAR;
  epi(acc, brow + wr * 64 + fr, bcol + wc * 32, fq);
  __syncthreads();
#undef SA
#undef SB
#undef STAGE
#undef STAGEB
#undef LDA
#undef LDB
#undef MMA
}

struct TileDesc { const bf16_t* A; const bf16_t* Bt; int brow, bcol, permb; };
#define CH_SA(b, h) (((b) * 2 + (h)) * HTB)
#define CH_SB(b, h) ((4 + (b) * 2 + (h)) * HTB)
#define CH_STAGE(bufoff, gbase, VO) do { _Pragma("unroll") for (int _i = 0; _i < 2; ++_i) \
    __builtin_amdgcn_global_load_lds((const unsigned*)((const char*)(gbase) + VO[_i]), (LAS unsigned*)(lds + (bufoff) + ldsw + _i * 8192), 16, 0, 0); } while (0)
__device__ __forceinline__ void gemm_prestage(const TileDesc& d) {
  constexpr int K = 1024;
  LAS unsigned char* lds = (LAS unsigned char*)smem;
  int tid = threadIdx.x; asm volatile("" : "+v"(tid));
  const int wid = __builtin_amdgcn_readfirstlane(tid >> 6);
  unsigned voff[2], vb[2];
#pragma unroll
  for (int i = 0; i < 2; ++i) { int R, C; stage_rc(tid * 16 + i * 8192, R, C); voff[i] = (unsigned)(R * K + C) * 2u;
    const int rho = R & 31, ii = rho & 15, Rb = d.permb ? ((R & ~31) + 8 * (ii >> 2) + 4 * (rho >> 4) + (ii & 3)) : R;
    vb[i] = (unsigned)(Rb * K + C) * 2u; }
  const size_t kstep = (size_t)(BK * 2), hstep = (size_t)HALF * K * 2;
  const unsigned ldsw = (unsigned)wid * 1024u;
  const char* cA = (const char*)d.A + (size_t)d.brow * K * 2; const char* cB = (const char*)d.Bt + (size_t)d.bcol * K * 2;
  CH_STAGE(CH_SB(0, 0), cB, vb); CH_STAGE(CH_SA(0, 0), cA, voff); CH_STAGE(CH_SB(0, 1), cB + hstep, vb); CH_STAGE(CH_SA(0, 1), cA + hstep, voff);
  CH_STAGE(CH_SB(1, 0), cB + kstep, vb); CH_STAGE(CH_SA(1, 0), cA + kstep, voff); CH_STAGE(CH_SB(1, 1), cB + hstep + kstep, vb);
}
template <class Epi>
__device__ __forceinline__ void gemm_chain(const TileDesc& d, const Epi& epi, const bool has_next, const TileDesc& nx) {
  constexpr int K = 1024;
  LAS unsigned char* lds = (LAS unsigned char*)smem;
  int tid = threadIdx.x; asm volatile("" : "+v"(tid));
  const int wid = __builtin_amdgcn_readfirstlane(tid >> 6), lane = tid & 63, wr = wid >> 2, wc = wid & 3, fr = lane & 15, fq = lane >> 4;
  unsigned voff[2], vb[2];
#pragma unroll
  for (int i = 0; i < 2; ++i) { int R, C; stage_rc(tid * 16 + i * 8192, R, C); voff[i] = (unsigned)(R * K + C) * 2u;
    const int rho = R & 31, ii = rho & 15, Rb = d.permb ? ((R & ~31) + 8 * (ii >> 2) + 4 * (rho >> 4) + (ii & 3)) : R;
    vb[i] = (unsigned)(Rb * K + C) * 2u; }
  const size_t kstep = (size_t)(BK * 2), hstep = (size_t)HALF * K * 2;
  const unsigned ldsw = (unsigned)wid * 1024u;
  const int aoff = lds_byte(wr * 64 + fr, fq * 8), boff = lds_byte(wc * 32 + fr, fq * 8);
  const char* cA = (const char*)d.A + (size_t)d.brow * K * 2; const char* cB = (const char*)d.Bt + (size_t)d.bcol * K * 2;
#define SA(b, h) CH_SA(b, h)
#define SB(b, h) CH_SB(b, h)
#define STAGE(bufoff, gbase) CH_STAGE(bufoff, gbase, voff)
#define STAGEB(bufoff, gbase) CH_STAGE(bufoff, gbase, vb)
#define LDA(dst, b, h) do { _Pragma("unroll") for (int m = 0; m < 4; ++m) _Pragma("unroll") for (int k = 0; k < 2; ++k) dst[m][k] = *(const LAS bf16x8*)(lds + SA(b, h) + aoff + m * 2048 + k * 1024); } while (0)
#define LDB(dst, b, h) do { _Pragma("unroll") for (int n = 0; n < 2; ++n) _Pragma("unroll") for (int k = 0; k < 2; ++k) dst[n][k] = *(const LAS bf16x8*)(lds + SB(b, h) + boff + n * 2048 + k * 1024); } while (0)
#define MMA(ai, bj, At_, Bt_) do { __builtin_amdgcn_s_setprio(1); _Pragma("unroll") for (int m = 0; m < 4; ++m) _Pragma("unroll") for (int n = 0; n < 2; ++n) _Pragma("unroll") for (int k = 0; k < 2; ++k) \
      acc[ai][bj][m][n] = __builtin_amdgcn_mfma_f32_16x16x32_bf16(Bt_[n][k], At_[m][k], acc[ai][bj][m][n], 0, 0, 0); \
    __builtin_amdgcn_s_setprio(0); } while (0)
  f32x4 acc[2][2][4][2];
#pragma unroll
  for (int a = 0; a < 2; ++a)
#pragma unroll
    for (int b = 0; b < 2; ++b)
#pragma unroll
      for (int m = 0; m < 4; ++m)
#pragma unroll
        for (int n = 0; n < 2; ++n) acc[a][b][m][n] = (f32x4){0.f, 0.f, 0.f, 0.f};
  bf16x8 At[4][2], B0[2][2], B1[2][2];
  constexpr int nt = K / BK;
  if (wr == 1) BAR;
  WAIT_V(10); BAR;
  WAIT_V(6); BAR;
  for (int t = 0; t < nt - 2; t += 2) {
    const char* a1 = cA + (size_t)(t + 1) * kstep; const char* a2 = a1 + kstep; const char* a3 = a2 + kstep;
    const char* b2 = cB + (size_t)(t + 2) * kstep; const char* b3 = b2 + kstep;
    LDB(B0, 0, 0); SCHED; LDA(At, 0, 0); STAGE(SA(1, 1), a1 + hstep);
    WAIT_L(8); BAR; WAIT_L(0); MMA(0, 0, At, B0); BAR; SCHED;
    LDB(B1, 0, 1); STAGEB(SB(0, 0), b2);
    BAR; WAIT_L(0); MMA(0, 1, At, B1); BAR;
    LDA(At, 0, 1); STAGE(SA(0, 0), a2);
    BAR; WAIT_L(0); MMA(1, 0, At, B0); BAR; SCHED;
    STAGEB(SB(0, 1), b2 + hstep);
    WAIT_V(6); BAR; MMA(1, 1, At, B1); BAR;
    LDB(B0, 1, 0); SCHED; LDA(At, 1, 0); STAGE(SA(0, 1), a2 + hstep);
    WAIT_L(8); BAR; WAIT_L(0); MMA(0, 0, At, B0); BAR; SCHED;
    LDB(B1, 1, 1); STAGEB(SB(1, 0), b3);
    BAR; WAIT_L(0); MMA(0, 1, At, B1); BAR;
    LDA(At, 1, 1); STAGE(SA(1, 0), a3);
    BAR; WAIT_L(0); MMA(1, 0, At, B0); BAR; SCHED;
    STAGEB(SB(1, 1), b3 + hstep);
    WAIT_V(6); BAR; MMA(1, 1, At, B1); BAR;
  }
  { LDB(B0, 0, 0); LDA(At, 0, 0); STAGE(SA(1, 1), cA + (size_t)(nt - 1) * kstep + hstep);
    BAR; WAIT_L(0); MMA(0, 0, At, B0); BAR;
    LDB(B1, 0, 1); BAR; WAIT_L(0); MMA(0, 1, At, B1); BAR;
    LDA(At, 0, 1); WAIT_V(4); BAR; WAIT_L(0); MMA(1, 0, At, B0); MMA(1, 1, At, B1); BAR; }
  { LDB(B0, 1, 0); LDA(At, 1, 0); WAIT_V(2); BAR; WAIT_L(0); MMA(0, 0, At, B0); BAR;
    LDB(B1, 1, 1); WAIT_V(0); BAR; WAIT_L(0); MMA(0, 1, At, B1); BAR;
    LDA(At, 1, 1); BAR; WAIT_L(0); MMA(1, 0, At, B0); MMA(1, 1, At, B1); BAR; }
  if (wr == 0) BAR;
  SCHED;
  if (has_next) gemm_prestage(nx);
  SCHED;
  epi(acc, d.brow + wr * 64 + fr, d.bcol + wc * 32, fq);
#undef SA
#undef SB
#undef STAGE
#undef STAGEB
#undef LDA
#undef LDB
#undef MMA
}

struct EpiInProj {
  bf16_t* proj; float* R; const float* b_gate; int pn;
  __device__ __forceinline__ void operator()(const f32x4 (&acc)[2][2][4][2], int row0, int colw, int fq) const {
    const int lc0 = colw - pn * 256 + fq * 8;
    if (pn < 16) {
      const bool bz = pn >= 8;
      const int cbase = (bz ? PC_BZ + (pn - 8) * 128 : PC_CX + pn * 128) + lc0;
#pragma unroll
      for (int ai = 0; ai < 2; ++ai)
#pragma unroll
        for (int m = 0; m < 4; ++m) {
          bf16_t* rp = proj + (size_t)(row0 + ai * HALF + m * 16) * LDP + cbase;
          float v[8];
#pragma unroll
          for (int n = 0; n < 2; ++n) {
            const f32x4 a = acc[ai][0][m][n], b = acc[ai][1][m][n];
            if (bz) { for (int j = 0; j < 4; ++j) v[n * 4 + j] = a[j] * silu_f(b[j]); }
            else { for (int j = 0; j < 4; ++j) v[n * 4 + j] = a[j] * b[j]; }
          }
          u32x4 w = {cvtpk(v[0], v[1]), cvtpk(v[2], v[3]), cvtpk(v[4], v[5]), cvtpk(v[6], v[7])};
          *reinterpret_cast<u32x4*>(rp) = w;
        }
      return;
    }
    if (pn == 50) {
      if (lc0 < 32) {
#pragma unroll
        for (int ai = 0; ai < 2; ++ai)
#pragma unroll
          for (int m = 0; m < 4; ++m)
#pragma unroll
            for (int n = 0; n < 2; ++n)
              *reinterpret_cast<f32x4*>(R + (size_t)(row0 + ai * HALF + m * 16) * 32 + lc0 + n * 4) = acc[ai][0][m][n];
      }
      return;
    }
    int mode, cb;
    if (pn < 20) { mode = 0; cb = PC_Q + (pn - 16) * 256; }
    else if (pn == 20) { mode = 0; cb = PC_K; }
    else if (pn == 21) { mode = 0; cb = PC_V; }
    else if (pn < 26) { mode = 1; cb = PC_ZA + (pn - 22) * 256; }
    else if (pn < 28) { mode = 0; cb = PC_GQ + (pn - 26) * 256; }
    else if (pn < 30) { mode = 0; cb = PC_GK + (pn - 28) * 256; }
    else if (pn < 34) { mode = 0; cb = PC_GV + (pn - 30) * 256; }
    else if (pn < 38) { mode = 1; cb = PC_ZG + (pn - 34) * 256; }
    else { mode = 2; cb = PC_MG + (pn - 38) * 256; }
    const int cbase = cb + lc0;
#pragma unroll
    for (int bj = 0; bj < 2; ++bj) {
      f32x4 bias0 = {0.f, 0.f, 0.f, 0.f}, bias1 = bias0;
      if (mode == 2) { const float* bp = b_gate + (pn - 38) * 256 + lc0 + bj * HALF;
        bias0 = *reinterpret_cast<const f32x4*>(bp); bias1 = *reinterpret_cast<const f32x4*>(bp + 4); }
#pragma unroll
      for (int ai = 0; ai < 2; ++ai)
#pragma unroll
        for (int m = 0; m < 4; ++m) {
          float v[8];
#pragma unroll
          for (int n = 0; n < 2; ++n) {
            const f32x4 a = acc[ai][bj][m][n]; const f32x4 bias = n ? bias1 : bias0;
            if (mode == 0) { for (int j = 0; j < 4; ++j) v[n * 4 + j] = a[j]; }
            else if (mode == 1) { for (int j = 0; j < 4; ++j) v[n * 4 + j] = silu_f(a[j]); }
            else { for (int j = 0; j < 4; ++j) v[n * 4 + j] = sigmoid_f(a[j] + bias[j]); }
          }
          u32x4 w = {cvtpk(v[0], v[1]), cvtpk(v[2], v[3]), cvtpk(v[4], v[5]), cvtpk(v[6], v[7])};
          *reinterpret_cast<u32x4*>(proj + (size_t)(row0 + ai * HALF + m * 16) * LDP + cbase + bj * HALF) = w;
        }
    }
  }
};
struct EpiMerge {
  const bf16_t* gate;
  bf16_t* M; int br;
  __device__ __forceinline__ void operator()(const f32x4 (&acc)[2][2][4][2], int row0, int colw, int fq) const {
#pragma unroll
    for (int ai = 0; ai < 2; ++ai)
#pragma unroll
      for (int m = 0; m < 4; ++m) {
        const size_t row = row0 + ai * HALF + m * 16;
#pragma unroll
        for (int bj = 0; bj < 2; ++bj) {
          const int col = colw + fq * 8 + bj * HALF;
          const u32x4 gw = *reinterpret_cast<const u32x4*>(gate + row * LDP + col);
          float v[8];
#pragma unroll
          for (int n = 0; n < 2; ++n) {
            const f32x4 a = acc[ai][bj][m][n];
            v[n * 4 + 0] = a[0] * bflo(gw[2 * n]); v[n * 4 + 1] = a[1] * bfhi(gw[2 * n]);
            v[n * 4 + 2] = a[2] * bflo(gw[2 * n + 1]); v[n * 4 + 3] = a[3] * bfhi(gw[2 * n + 1]);
          }
          bf16_t* mp = M + row * 1024 + col;
          if (br != 0) {
            const u32x4 o = *reinterpret_cast<const u32x4*>(mp);
#pragma unroll
            for (int q = 0; q < 4; ++q) { v[2 * q] += bflo(o[q]); v[2 * q + 1] += bfhi(o[q]); }
          }
          u32x4 w = {cvtpk(v[0], v[1]), cvtpk(v[2], v[3]), cvtpk(v[4], v[5]), cvtpk(v[6], v[7])};
          *reinterpret_cast<u32x4*>(mp) = w;
        }
      }
  }
};
struct EpiOutF {
  bf16_t* O;
  __device__ __forceinline__ void operator()(const f32x4 (&acc)[2][2][4][2], int row0, int colw, int fq) const {
#pragma unroll
    for (int ai = 0; ai < 2; ++ai)
#pragma unroll
      for (int m = 0; m < 4; ++m)
#pragma unroll
        for (int bj = 0; bj < 2; ++bj) {
          const f32x4 a = acc[ai][bj][m][0], b = acc[ai][bj][m][1];
          u32x4 w = {cvtpk(a[0], a[1]), cvtpk(a[2], a[3]), cvtpk(b[0], b[1]), cvtpk(b[2], b[3])};
          *reinterpret_cast<u32x4*>(O + (size_t)(row0 + ai * HALF + m * 16) * 1024 + colw + fq * 8 + bj * HALF) = w;
        }
  }
};

__device__ __forceinline__ void half_src(int ht, int& src, int& valid) {
  const int pn = ht >> 1, hf = ht & 1; valid = 128;
  if (pn < 8) src = (hf ? 2048 : 1024) + 128 * pn;
  else if (pn < 16) src = (hf ? 3072 : 0) + 128 * (pn - 8);
  else if (pn < 20) src = 4096 + (pn - 16) * 256 + hf * 128;
  else if (pn == 20) src = 5120 + hf * 128;
  else if (pn == 21) src = 5376 + hf * 128;
  else if (pn < 26) src = 5632 + (pn - 22) * 256 + hf * 128;
  else if (pn < 28) src = 6656 + (pn - 26) * 256 + hf * 128;
  else if (pn < 30) src = 7168 + (pn - 28) * 256 + hf * 128;
  else if (pn < 34) src = 7680 + (pn - 30) * 256 + hf * 128;
  else if (pn < 38) src = 8736 + (pn - 34) * 256 + hf * 128;
  else if (pn < 50) src = 9760 + (pn - 38) * 256 + hf * 128;
  else { src = 8704; valid = hf ? 0 : 32; }
}
constexpr int P0_TS = 260, P0_TILE = 64 * P0_TS;
constexpr int P0_MOD = 96, P0_WIN = 2 * 16 * 51, P0_WBR = 6 * 64, P0_WOUT = 2 * 64;
__device__ __forceinline__ void p0_lane(const Params& p, int it, int wave, int lane, int tid, const float*& lp, int& ld, bool& ok, bf16_t*& dp) {
  const float* src; bf16_t* dst; int s0, v0, s1, v1, k0;
  if (it < P0_MOD + P0_WIN) {
    const int i = it - P0_MOD, l = i / 816, r = i % 816, kb = r / 51, pn = r % 51;
    half_src(2 * pn, s0, v0); half_src(2 * pn + 1, s1, v1);
    src = p.w_in + (size_t)l * 1024 * INW; ld = INW; k0 = kb * 64; dst = (bf16_t*)(p.ws + WS_WTIN) + ((size_t)l * NPAD + pn * 256) * 1024;
  } else if (it < P0_MOD + P0_WIN + P0_WBR) {
    const int i = it - P0_MOD - P0_WIN, m = i / 64, r = i % 64, kb = r / 4, nt = r % 4, l = m / 3, br = m % 3;
    src = (br == 0 ? p.w_bc : (br == 1 ? p.w_ba : p.w_bg)) + (size_t)l * 1024 * 1024; ld = 1024;
    s0 = nt * 256; v0 = 128; s1 = nt * 256 + 128; v1 = 128; k0 = kb * 64; dst = (bf16_t*)(p.ws + WS_WTBR) + ((size_t)m * 1024 + nt * 256) * 1024;
  } else {
    const int i = it - P0_MOD - P0_WIN - P0_WBR, l = i / 64, r = i % 64, kb = r / 4, nt = r % 4;
    src = p.w_out + (size_t)l * 1024 * 1024; ld = 1024;
    s0 = nt * 256; v0 = 128; s1 = nt * 256 + 128; v1 = 128; k0 = kb * 64; dst = (bf16_t*)(p.ws + WS_WTOUT) + ((size_t)l * 1024 + nt * 256) * 1024;
  }
  const int half = lane >> 5, c4 = (lane & 31) * 4;
  lp = src + (size_t)(k0 + wave * 8) * ld + (half ? s1 : s0) + c4; ok = c4 < (half ? v1 : v0);
  dp = dst + (size_t)(tid & 255) * 1024 + k0 + (tid >> 8) * 32;
}
__device__ __forceinline__ void p0_store(const float* t, bf16_t* dp, int tid) {
  const int n = tid & 255, kh = (tid >> 8) * 32, rho = n & 31, ii = rho & 15;
  const int nsrc = (n & ~31) + 8 * (ii >> 2) + 4 * (rho >> 4) + (ii & 3);
#pragma unroll
  for (int q = 0; q < 4; ++q) {
    float v[8];
#pragma unroll
    for (int i = 0; i < 8; ++i) v[i] = t[(kh + q * 8 + i) * P0_TS + nsrc];
    u32x4 w = {cvtpk(v[0], v[1]), cvtpk(v[2], v[3]), cvtpk(v[4], v[5]), cvtpk(v[6], v[7])};
    *reinterpret_cast<u32x4*>(dp + q * 8) = w;
  }
}
__device__ __forceinline__ void phase0(const Params& p) {
  int tid_ = threadIdx.x; asm volatile("" : "+v"(tid_)); const int tid = tid_, wave = tid >> 6, lane = tid & 63;
  float* mod = (float*)(p.ws + WS_MOD);
  const int total = P0_MOD + P0_WIN + P0_WBR + P0_WOUT;
  int it = blockIdx.x;
  if (it < P0_MOD) {
    const int i = it, l = i / 48, cb = i % 48;
    float* sv = (float*)smem;
    float* red = sv + 9 * 1024;
    for (int e = tid; e < 9 * 1024; e += 512) {
      const int j = e >> 10, k = e & 1023;
      const float v = j < 8 ? p.c[j * 1024 + k] : p.c_ctx[k];
      sv[e] = silu_f(v);
    }
    __syncthreads();
    const int col = tid & 63, ks = tid >> 6;
    float a[9];
#pragma unroll
    for (int j = 0; j < 9; ++j) a[j] = 0.f;
    const float* wp = p.w_ada + (size_t)l * 1024 * 3072 + cb * 64 + col;
#pragma unroll 8
    for (int k = ks * 128; k < ks * 128 + 128; ++k) {
      const float w = wp[(size_t)k * 3072];
#pragma unroll
      for (int j = 0; j < 9; ++j) a[j] += sv[j * 1024 + k] * w;
    }
#pragma unroll
    for (int j = 0; j < 9; ++j) red[(ks * 9 + j) * 64 + col] = a[j];
    __syncthreads();
    for (int e = tid; e < 576; e += 512) {
      const int j = e >> 6, cc = e & 63;
      float s = p.b_ada[l * 3072 + cb * 64 + cc];
#pragma unroll
      for (int q = 0; q < 8; ++q) s += red[(q * 9 + j) * 64 + cc];
      mod[((size_t)l * 9 + j) * 3072 + cb * 64 + cc] = s;
    }
    __syncthreads();
    it += gridDim.x;
  }
  float* tA = (float*)smem; float* tB = tA + P0_TILE;
  const int half = lane >> 5, c4 = (lane & 31) * 4;
  for (; it < total; it += 2 * gridDim.x) {
    const int itB = it + gridDim.x; const bool hasB = itB < total;
    const float* lpA; const float* lpB = nullptr; int ldA, ldB = 0; bool okA, okB = false; bf16_t* dpA; bf16_t* dpB = nullptr;
    p0_lane(p, it, wave, lane, tid, lpA, ldA, okA, dpA);
    if (hasB) p0_lane(p, itB, wave, lane, tid, lpB, ldB, okB, dpB);
    f32x4 va[8], vb[8];
#pragma unroll
    for (int i = 0; i < 8; ++i) va[i] = okA ? *reinterpret_cast<const f32x4*>(lpA + (size_t)i * ldA) : f32x4{0.f, 0.f, 0.f, 0.f};
    if (hasB) {
#pragma unroll
      for (int i = 0; i < 8; ++i) vb[i] = okB ? *reinterpret_cast<const f32x4*>(lpB + (size_t)i * ldB) : f32x4{0.f, 0.f, 0.f, 0.f};
    }
#pragma unroll
    for (int i = 0; i < 8; ++i) *reinterpret_cast<f32x4*>(tA + (wave * 8 + i) * P0_TS + half * 128 + c4) = va[i];
    if (hasB) {
#pragma unroll
      for (int i = 0; i < 8; ++i) *reinterpret_cast<f32x4*>(tB + (wave * 8 + i) * P0_TS + half * 128 + c4) = vb[i];
    }
    __syncthreads();
    p0_store(tA, dpA, tid);
    if (hasB) p0_store(tB, dpB, tid);
    __syncthreads();
  }
}

__device__ __forceinline__ void norm_rows(const Params& p, int g, int mode, int r0, int r1, int slot, int nslot) {
  int tid_ = threadIdx.x; asm volatile("" : "+v"(tid_)); const int tid = tid_, wave = tid >> 6, lane = tid & 63;
  const float* mod = (const float*)(p.ws + WS_MOD);
  const bf16_t* outf = (const bf16_t*)(p.ws + WS_OUTF);
  bf16_t* H = (bf16_t*)(p.ws + WS_H);
  for (int row = r0 + slot * 8 + wave; row < r1; row += nslot * 8) {
    const bool lat = row < NLAT;
    const int bl = lat ? (row >> 12) : ((row - NLAT) >> 8);
    const int b = 2 * g + bl, j = lat ? b : 8;
    const size_t xoff = lat ? ((size_t)b * SEQ + (row & 4095)) * 1024 : ((size_t)b * CTXL + ((row - NLAT) & 255)) * 1024;
    f32x4 v[4];
    if (mode == 2) {
#pragma unroll
      for (int i = 0; i < 4; ++i) v[i] = *reinterpret_cast<const f32x4*>(p.out + xoff + i * 256 + lane * 4);
    } else {
      const float* xin = (lat ? p.x : p.ctx) + xoff;
#pragma unroll
      for (int i = 0; i < 4; ++i) v[i] = *reinterpret_cast<const f32x4*>(xin + i * 256 + lane * 4);
    }
    if (mode >= 1) {
      const int lp = mode - 1;
      f32x4 o[4]; float ss = 0.f;
#pragma unroll
      for (int i = 0; i < 4; ++i) { const u32x2 ow = *reinterpret_cast<const u32x2*>(outf + (size_t)row * 1024 + i * 256 + lane * 4);
        o[i] = f32x4{bflo(ow[0]), bfhi(ow[0]), bflo(ow[1]), bfhi(ow[1])};
        for (int q = 0; q < 4; ++q) ss += o[i][q] * o[i][q]; }
      ss = wave_sum(ss);
      const float rs = rsqrtf(ss * (1.f / 1024.f) + EPS);
      const float* gt = mod + ((size_t)lp * 9 + j) * 3072 + 2048;
      const float* gp = p.g_post + lp * 1024;
#pragma unroll
      for (int i = 0; i < 4; ++i) {
        const f32x4 gtv = *reinterpret_cast<const f32x4*>(gt + i * 256 + lane * 4);
        const f32x4 gpv = *reinterpret_cast<const f32x4*>(gp + i * 256 + lane * 4);
        for (int q = 0; q < 4; ++q) v[i][q] += gtv[q] * (o[i][q] * rs * gpv[q]);
      }
      if (lat) {
#pragma unroll
        for (int i = 0; i < 4; ++i) *reinterpret_cast<f32x4*>(p.out + xoff + i * 256 + lane * 4) = v[i];
      }
    }
    if (mode <= 1) {
      const int l = mode;
      float ss = 0.f;
#pragma unroll
      for (int i = 0; i < 4; ++i) for (int q = 0; q < 4; ++q) ss += v[i][q] * v[i][q];
      ss = wave_sum(ss);
      const float rs = rsqrtf(ss * (1.f / 1024.f) + EPS);
      const float* sh = mod + ((size_t)l * 9 + j) * 3072;
      const float* sc = sh + 1024;
      const float* gp = p.g_pre + l * 1024;
#pragma unroll
      for (int i = 0; i < 4; ++i) {
        const f32x4 shv = *reinterpret_cast<const f32x4*>(sh + i * 256 + lane * 4);
        const f32x4 scv = *reinterpret_cast<const f32x4*>(sc + i * 256 + lane * 4);
        const f32x4 gpv = *reinterpret_cast<const f32x4*>(gp + i * 256 + lane * 4);
        float h[4];
        for (int q = 0; q < 4; ++q) h[q] = (v[i][q] * rs * gpv[q]) * (1.f + scv[q]) + shv[q];
        u32x2 w = {cvtpk(h[0], h[1]), cvtpk(h[2], h[3])};
        *reinterpret_cast<u32x2*>(H + (size_t)row * 1024 + i * 256 + lane * 4) = w;
      }
    }
  }
}

__device__ __forceinline__ void norm_phase(const Params& p, int g, int mode) {
  norm_rows(p, g, mode, 0, (mode == 2) ? NLAT : GROWS, blockIdx.x, gridDim.x);
}

struct EpiVT {
  bf16_t* VT; int ch0;
  __device__ __forceinline__ void operator()(const f32x4 (&acc)[2][2][4][2], int row0, int colw, int fq) const {
    const int fr = row0 & 15;
#pragma unroll
    for (int ai = 0; ai < 2; ++ai)
#pragma unroll
      for (int m = 0; m < 4; ++m) {
        const int prow = row0 + ai * HALF + m * 16;
        const int ch = (prow & ~31) + 8 * (fr >> 2) + 4 * (m & 1) + (fr & 3) - ch0;
        bf16_t* rp = VT + (size_t)ch * GROWS + colw + fq * 8;
#pragma unroll
        for (int bj = 0; bj < 2; ++bj) {
          const f32x4 a = acc[ai][bj][m][0], b = acc[ai][bj][m][1];
          u32x4 w = {cvtpk(a[0], a[1]), cvtpk(a[2], a[3]), cvtpk(b[0], b[1]), cvtpk(b[2], b[3])};
          *reinterpret_cast<u32x4*>(rp + bj * HALF) = w;
        }
      }
  }
};
__device__ __forceinline__ bool inproj_desc(const bf16_t* H, const bf16_t* W, int l, int L, TileDesc& d, int& pn_out) {
  const int nMl = (l == 0 ? GROWS : NLAT) / 256, nN = (l == 0 ? 41 : 43), nreg = nMl * nN, nctx = (l == 0 ? 0 : 10), nvt = 4 * (GROWS / 256);
  if (L < nreg) {
    int pm, pn; tile_of(L, nMl, nN, pm, pn);
    pn = pn < 30 ? pn : (pn < 40 ? pn + 4 : (pn == 40 ? 50 : pn + 3));
    d.A = H; d.Bt = W; d.brow = pm * 256; d.bcol = pn * 256; d.permb = 0; pn_out = pn; return true;
  }
  if (L < nreg + nctx) {
    const int idx = L - nreg, pm = 32 + idx / 5, c = idx % 5;
    const int pn = c == 0 ? 20 : (c == 1 ? 21 : (c == 2 ? 28 : (c == 3 ? 29 : 50)));
    d.A = H; d.Bt = W; d.brow = pm * 256; d.bcol = pn * 256; d.permb = 0; pn_out = pn; return true;
  }
  if (L < nreg + nctx + nvt) {
    const int idx0 = L - nreg - nctx, idx = (idx0 & 7) * 17 + (idx0 >> 3), ct = idx & 3, pm = idx >> 2;
    d.A = W; d.Bt = H; d.brow = (30 + ct) * 256; d.bcol = pm * 256; d.permb = 1; pn_out = -1; return true;
  }
  return false;
}
__device__ __forceinline__ void inproj_phase(const Params& p, int l) {
  const bf16_t* H = (const bf16_t*)(p.ws + WS_H);
  const bf16_t* W = (const bf16_t*)(p.ws + WS_WTIN) + (size_t)l * NPAD * 1024;
  EpiInProj epi; epi.proj = (bf16_t*)(p.ws + WS_PROJ); epi.R = (float*)(p.ws + WS_R); epi.b_gate = p.b_gate + l * 3072;
  EpiVT epv; epv.VT = (bf16_t*)(p.ws + WS_VT); epv.ch0 = 30 * 256;
  TileDesc cur, nxt; int pn, pnn;
  bool have = inproj_desc(H, W, l, blockIdx.x, cur, pn);
  if (have) gemm_prestage(cur);
  for (int i = 1; have; ++i) {
    const bool hn = inproj_desc(H, W, l, i * gridDim.x + blockIdx.x, nxt, pnn);
    if (pn >= 0) { epi.pn = pn; gemm_chain(cur, epi, hn, nxt); }
    else gemm_chain(cur, epv, hn, nxt);
    cur = nxt; pn = pnn; have = hn;
  }
  __syncthreads();
}

__device__ __forceinline__ void inproj_deferred_tile(const Params& p, int l, int idx0, int ndef) {
  const int x = idx0 & 7, s = idx0 >> 3, base = ndef >> 3, rem = ndef & 7;
  const int idx = x * base + (x < rem ? x : rem) + s;
  const bf16_t* H = (const bf16_t*)(p.ws + WS_H);
  const bf16_t* W = (const bf16_t*)(p.ws + WS_WTIN) + (size_t)l * NPAD * 1024;
  EpiInProj epi; epi.proj = (bf16_t*)(p.ws + WS_PROJ); epi.R = (float*)(p.ws + WS_R); epi.b_gate = p.b_gate + l * 3072;
  const int nc = (l == 0 ? 6 : 4), pm = idx / nc, pn = (l == 0 ? 44 : 46) + idx % nc;
  epi.pn = pn;
  gemm_tile(H, W, 1024, pm * 256, pn * 256, epi);
}

template <int DIR>
__device__ __forceinline__ void glaprep_item(const Params& p, int l, int chunk) {
  int tid_ = threadIdx.x; asm volatile("" : "+v"(tid_)); const int tid = tid_, c4 = tid & 127, tg = tid >> 7;
  const bf16_t* proj = (const bf16_t*)(p.ws + WS_PROJ);
  const float* R = (const float*)(p.ws + WS_R);
  bf16_t* QT = (bf16_t*)(p.ws + WS_QT) + (size_t)DIR * GROWS * 512;
  bf16_t* KT = (bf16_t*)(p.ws + WS_KT) + (size_t)DIR * GROWS * 512;
  bf16_t* KTT = (bf16_t*)(p.ws + WS_KTT) + ((size_t)DIR * 136 + chunk) * 512 * 64;
  float* E = (float*)(p.ws + WS_E) + ((size_t)DIR * 136 + chunk) * 512;
  float* Rs = (float*)smem;
  float* tot = Rs + 1024;
  const int row0 = chunk * 64;
  for (int i = tid; i < 1024; i += 512) Rs[i] = R[(size_t)(row0 + (i >> 4)) * 32 + DIR * 16 + (i & 15)];
  const float* wd = (DIR ? p.w_db : p.w_df) + (size_t)l * 16 * 512 + c4 * 4;
  f32x4 w[16];
#pragma unroll
  for (int j = 0; j < 16; ++j) w[j] = *reinterpret_cast<const f32x4*>(wd + j * 512);
  const f32x4 bb = *reinterpret_cast<const f32x4*>((DIR ? p.b_db : p.b_df) + l * 512 + c4 * 4);
  __syncthreads();
  f32x4 lc[16]; f32x4 cum = {0.f, 0.f, 0.f, 0.f};
#pragma unroll
  for (int k = 0; k < 16; ++k) {
    const int tt = DIR ? 63 - (tg * 16 + k) : tg * 16 + k;
    f32x4 z = bb;
#pragma unroll
    for (int j = 0; j < 16; ++j) { const float r = Rs[tt * 16 + j]; z += r * w[j]; }
#pragma unroll
    for (int c = 0; c < 4; ++c) cum[c] += (fminf(z[c], 0.f) - __logf(1.f + __expf(-fabsf(z[c])))) * (1.f / 16.f);
    lc[k] = cum;
  }
  *reinterpret_cast<f32x4*>(tot + tg * 512 + c4 * 4) = cum;
  __syncthreads();
  f32x4 pre = {0.f, 0.f, 0.f, 0.f}, all = {0.f, 0.f, 0.f, 0.f};
#pragma unroll
  for (int g = 0; g < 4; ++g) { const f32x4 t4 = *reinterpret_cast<const f32x4*>(tot + g * 512 + c4 * 4); all += t4; if (g < tg) pre += t4; }
  unsigned ktw[4][8];
#pragma unroll
  for (int c = 0; c < 4; ++c)
#pragma unroll
    for (int q = 0; q < 8; ++q) ktw[c][q] = 0u;
#pragma unroll
  for (int k = 0; k < 16; ++k) {
    const int tt = DIR ? 63 - (tg * 16 + k) : tg * 16 + k;
    const size_t row = row0 + tt;
    const u32x2 qw = *reinterpret_cast<const u32x2*>(proj + row * LDP + PC_GQ + c4 * 4);
    const u32x2 kw = *reinterpret_cast<const u32x2*>(proj + row * LDP + PC_GK + c4 * 4);
    const f32x4 cm = pre + lc[k];
    float qv[4] = {bflo(qw[0]), bfhi(qw[0]), bflo(qw[1]), bfhi(qw[1])};
    float kv[4] = {bflo(kw[0]), bfhi(kw[0]), bflo(kw[1]), bfhi(kw[1])};
#pragma unroll
    for (int c = 0; c < 4; ++c) { qv[c] *= 0.08838834764831845f * __expf(cm[c]); kv[c] *= __expf(-cm[c]); }
    u32x2 qo = {cvtpk(qv[0], qv[1]), cvtpk(qv[2], qv[3])}, ko = {cvtpk(kv[0], kv[1]), cvtpk(kv[2], kv[3])};
    *reinterpret_cast<u32x2*>(QT + row * 512 + c4 * 4) = qo;
    *reinterpret_cast<u32x2*>(KT + row * 512 + c4 * 4) = ko;
    constexpr int dummy = 0; (void)dummy;
    const int nk = DIR ? 15 - k : k;
    ktw[0][nk >> 1] |= (ko[0] & 0xffffu) << (16 * (nk & 1));
    ktw[1][nk >> 1] |= (ko[0] >> 16) << (16 * (nk & 1));
    ktw[2][nk >> 1] |= (ko[1] & 0xffffu) << (16 * (nk & 1));
    ktw[3][nk >> 1] |= (ko[1] >> 16) << (16 * (nk & 1));
  }
  const int base_tok = DIR ? 48 - tg * 16 : tg * 16;
#pragma unroll
  for (int c = 0; c < 4; ++c) {
    bf16_t* dst = KTT + (size_t)(c4 * 4 + c) * 64 + base_tok;
    u32x4 a = {ktw[c][0], ktw[c][1], ktw[c][2], ktw[c][3]}, b = {ktw[c][4], ktw[c][5], ktw[c][6], ktw[c][7]};
    *reinterpret_cast<u32x4*>(dst) = a; *reinterpret_cast<u32x4*>(dst + 8) = b;
  }
  if (tg == 0) {
    f32x4 ev; for (int c = 0; c < 4; ++c) ev[c] = __expf(all[c]);
    *reinterpret_cast<f32x4*>(E + c4 * 4) = ev;
  }
  __syncthreads();
}
__device__ __forceinline__ void prep_phase(const Params& p, int l) {
  for (int it = blockIdx.x; it < 272; it += gridDim.x) {
    if (it & 1) glaprep_item<1>(p, l, it >> 1); else glaprep_item<0>(p, l, it >> 1);
  }
  int tid_ = threadIdx.x; asm volatile("" : "+v"(tid_)); const int tid = tid_, wave = tid >> 6, lane = tid & 63;
  bf16_t* proj = (bf16_t*)(p.ws + WS_PROJ);
  bf16_t* kbuf = (bf16_t*)(p.ws + WS_KBUF); bf16_t* vbuf = (bf16_t*)(p.ws + WS_VBUF);
  bf16_t* UA = (bf16_t*)(p.ws + WS_UA);
  const float* qg = p.q_g + l * 128; const float* kg = p.k_g + l * 128;
  const float* cw = p.conv_w + l * 3 * 1024;
  const int axis = lane >> 5, pp = lane & 31;
  const float g1q = qg[axis * 64 + pp], g2q = qg[axis * 64 + 32 + pp];
  const float g1k = kg[axis * 64 + pp], g2k = kg[axis * 64 + 32 + pp];
  const float freq = exp2f(-(float)pp * (13.287712379549449f / 32.f));
  const int nrg = GROWS / 8, bb = blockIdx.x;
  for (int k = 0;; ++k) {
    int rg;
    if (gridDim.x == 256) { if (bb < 16) { if (k >= 2) break; rg = bb * 2 + k; } else { rg = 32 + (bb - 16) + k * 240; if (rg >= nrg) break; } }
    else { rg = bb + k * gridDim.x; if (rg >= nrg) break; }
    const int row = rg * 8 + wave;
    const bool lat = row < NLAT;
    const int bl = lat ? (row >> 12) : ((row - NLAT) >> 8);
    const int t = lat ? (row & 4095) : ((row - NLAT) & 255);
    const int slen = lat ? SEQ : CTXL;
    float cs = 1.f, sn = 0.f;
    if (lat) {
      const float pos = (float)(axis == 0 ? (t >> 6) : (t & 63));
      float ang = pos * freq;
      const float n = rintf(ang * 0.15915494309189535f);
      ang = fmaf(n, -6.28318548202514648f, ang); ang = fmaf(n, 1.7484555e-7f, ang);
      cs = __cosf(ang); sn = __sinf(ang);
    }
    bf16_t* prow = proj + (size_t)row * LDP;
    float x1[10], x2[10];
#pragma unroll
    for (int hh = 0; hh < 10; ++hh) {
      const int base = PC_Q + hh * 128 + axis * 64 + pp;
      x1[hh] = bf2f(prow[base]); x2[hh] = bf2f(prow[base + 32]);
    }
    const int kpos = lat ? t : SEQ + t;
#pragma unroll
    for (int hh = 0; hh < 10; ++hh) {
      const float ss = wave_sum(x1[hh] * x1[hh] + x2[hh] * x2[hh]);
      const float rs = rsqrtf(ss * (1.f / 128.f) + EPS);
      const float y1 = x1[hh] * rs * (hh < 8 ? g1q : g1k), y2 = x2[hh] * rs * (hh < 8 ? g2q : g2k);
      const bf16_t o1 = f2bf(y1 * cs - y2 * sn), o2 = f2bf(y2 * cs + y1 * sn);
      if (hh < 8) { const int base = PC_Q + hh * 128 + axis * 64 + pp; prow[base] = o1; prow[base + 32] = o2; }
      else { bf16_t* kd = kbuf + ((size_t)(bl * 2 + (hh - 8)) * SKV + kpos) * 128 + axis * 64 + pp; kd[0] = o1; kd[32] = o2; }
    }
    {
      const int kh = lane >> 5, d = (lane & 31) * 4;
      const u32x2 w = *reinterpret_cast<const u32x2*>(prow + PC_V + lane * 4);
      *reinterpret_cast<u32x2*>(vbuf + ((size_t)(bl * 2 + kh) * SKV + kpos) * 128 + d) = w;
    }
#pragma unroll
    for (int i = 0; i < 2; ++i) {
      const int c0 = i * 512 + lane * 8;
      const u32x4 z4 = {0u, 0u, 0u, 0u};
      const u32x4 cm = (t > 0) ? *reinterpret_cast<const u32x4*>(prow - LDP + PC_CX + c0) : z4;
      const u32x4 cc = *reinterpret_cast<const u32x4*>(prow + PC_CX + c0);
      const u32x4 cp = (t < slen - 1) ? *reinterpret_cast<const u32x4*>(prow + LDP + PC_CX + c0) : z4;
      const u32x4 bz = *reinterpret_cast<const u32x4*>(prow + PC_BZ + c0);
      float o[8];
      const f32x4 w0a = *reinterpret_cast<const f32x4*>(cw + c0), w0b = *reinterpret_cast<const f32x4*>(cw + c0 + 4);
      const f32x4 w1a = *reinterpret_cast<const f32x4*>(cw + 1024 + c0), w1b = *reinterpret_cast<const f32x4*>(cw + 1024 + c0 + 4);
      const f32x4 w2a = *reinterpret_cast<const f32x4*>(cw + 2048 + c0), w2b = *reinterpret_cast<const f32x4*>(cw + 2048 + c0 + 4);
#pragma unroll
      for (int q = 0; q < 4; ++q) {
        const float wl0 = q < 2 ? w0a[2 * q] : w0b[2 * q - 4], wh0 = q < 2 ? w0a[2 * q + 1] : w0b[2 * q - 3];
        const float wl1 = q < 2 ? w1a[2 * q] : w1b[2 * q - 4], wh1 = q < 2 ? w1a[2 * q + 1] : w1b[2 * q - 3];
        const float wl2 = q < 2 ? w2a[2 * q] : w2b[2 * q - 4], wh2 = q < 2 ? w2a[2 * q + 1] : w2b[2 * q - 3];
        o[2 * q] = bflo(bz[q]) * (wl0 * bflo(cm[q]) + wl1 * bflo(cc[q]) + wl2 * bflo(cp[q]));
        o[2 * q + 1] = bfhi(bz[q]) * (wh0 * bfhi(cm[q]) + wh1 * bfhi(cc[q]) + wh2 * bfhi(cp[q]));
      }
      u32x4 w = {cvtpk(o[0], o[1]), cvtpk(o[2], o[3]), cvtpk(o[4], o[5]), cvtpk(o[6], o[7])};
      *reinterpret_cast<u32x4*>(UA + (size_t)row * 1024 + c0) = w;
    }
  }
}

constexpr int AD = 128, ANW = 8, QBLK = 32, KVBLK = 64;
constexpr float ASCALE = 0.088388347648318440f;
constexpr float ATHR = 8.f;
constexpr int LDQ = LDP, LDK = 128;
constexpr size_t SHM_V = KVBLK * AD * 2, SHM_K = KVBLK * AD * 2;
#define KSWZ(row, colB) ((row) * 256 + ((colB) ^ (((row) & 7) << 4)))
#define SBAR() __builtin_amdgcn_sched_barrier(0)
__device__ __forceinline__ int crow(int r, int hi) { return (r & 3) + 8 * (r >> 2) + 4 * hi; }
__device__ __forceinline__ void partialSM(f32x16& p0, f32x16& p1, float& m_reg, float& mn, float& alpha) {
  constexpr float C = ASCALE * 1.4426950408889634f;
  float pmax = p0[0]; for (int r = 1; r < 16; ++r) pmax = fmaxf(pmax, p0[r]); for (int r = 0; r < 16; ++r) pmax = fmaxf(pmax, p1[r]);
  { auto rr = __builtin_amdgcn_permlane32_swap(__float_as_uint(pmax), __float_as_uint(pmax), false, false);
    pmax = fmaxf(__uint_as_float(rr[0]), __uint_as_float(rr[1])); }
  if (__builtin_expect(__all(pmax - m_reg <= ATHR / ASCALE), 1)) { mn = m_reg; alpha = 1.f; }
  else { mn = fmaxf(m_reg, pmax); alpha = __builtin_amdgcn_exp2f((m_reg - mn) * C); m_reg = mn; }
  float mnC = -mn * C;
  for (int r = 0; r < 16; ++r) p0[r] = fmaf(p0[r], C, mnC); for (int r = 0; r < 16; ++r) p1[r] = fmaf(p1[r], C, mnC);
  for (int r = 0; r < 16; ++r) p0[r] = __builtin_amdgcn_exp2f(p0[r]);
}
__device__ __forceinline__ void finishSM(f32x16& p0, f32x16& p1, float alpha, float& l_reg, bf16x8& pa0, bf16x8& pa1, bf16x8& pa2, bf16x8& pa3) {
  for (int r = 0; r < 16; ++r) p1[r] = __builtin_amdgcn_exp2f(p1[r]);
  float ps = 0; for (int r = 0; r < 16; ++r) ps += p0[r]; for (int r = 0; r < 16; ++r) ps += p1[r];
  { auto rr = __builtin_amdgcn_permlane32_swap(__float_as_uint(ps), __float_as_uint(ps), false, false);
    ps = __uint_as_float(rr[0]) + __uint_as_float(rr[1]); }
  l_reg = l_reg * alpha + ps;
#define PK4(P, BASE, OUT) do { unsigned a0 = cvtpk(P[BASE + 0], P[BASE + 1]), a1 = cvtpk(P[BASE + 2], P[BASE + 3]);   \
    unsigned b0 = cvtpk(P[BASE + 4], P[BASE + 5]), b1 = cvtpk(P[BASE + 6], P[BASE + 7]);                              \
    auto r0 = __builtin_amdgcn_permlane32_swap(a0, b0, false, false); auto r1 = __builtin_amdgcn_permlane32_swap(a1, b1, false, false); \
    u32x4 w = {r0[0], r1[0], r0[1], r1[1]}; OUT = *reinterpret_cast<bf16x8*>(&w); } while (0)
  PK4(p0, 0, pa0); PK4(p0, 8, pa1); PK4(p1, 0, pa2); PK4(p1, 8, pa3);
#undef PK4
}
__device__ __forceinline__ void qkt(f32x16& p0, f32x16& p1, const bf16_t* Ks, const bf16x8* qr, int r32, int hi) {
  p0 = f32x16{}; p1 = f32x16{};
  for (int d0 = 0; d0 < 8; ++d0) { int cb = (d0 * 16 + hi * 8) * 2;
    bf16x8 b0 = *reinterpret_cast<const bf16x8*>((const char*)Ks + KSWZ(r32, cb));
    bf16x8 b1 = *reinterpret_cast<const bf16x8*>((const char*)Ks + KSWZ(32 + r32, cb));
    p0 = __builtin_amdgcn_mfma_f32_32x32x16_bf16(b0, qr[d0], p0, 0, 0, 0);
    p1 = __builtin_amdgcn_mfma_f32_32x32x16_bf16(b1, qr[d0], p1, 0, 0, 0); }
}
__device__ __forceinline__ int v_st(int k, int c) { const int kk = (k & ~0xC) | ((k & 4) << 1) | ((k & 8) >> 1); return ((kk >> 3) * 4 + (c >> 5)) * 512 + ((kk & 7) * 32 + (c & 31)) * 2; }
__device__ __forceinline__ int v_rd_base(int lane) { return ((lane & 3) << 3) | (((lane >> 2) & 3) << 6) | (((lane >> 4) & 1) << 5) | (((lane >> 5) & 1) << 8); }
constexpr int v_rd_off(int d0, int ks, int half) { return d0 * 512 + ks * 4096 + half * 2048; }
template <int OFF> __device__ __forceinline__ s16x4 tr_read(int vb) {
  s16x4 r; asm volatile("ds_read_b64_tr_b16 %0, %1 offset:%2" : "=&v"(r) : "v"(vb), "i"(OFF) : "memory"); return r;
}
template <int D0> __device__ __forceinline__ void pv_one(f32x16& od, int vb, bf16x8 pa0, bf16x8 pa1, bf16x8 pa2, bf16x8 pa3) {
  const s16x4 l0 = tr_read<v_rd_off(D0, 0, 0)>(vb), h0 = tr_read<v_rd_off(D0, 0, 1)>(vb), l1 = tr_read<v_rd_off(D0, 1, 0)>(vb), h1 = tr_read<v_rd_off(D0, 1, 1)>(vb);
  const s16x4 l2 = tr_read<v_rd_off(D0, 2, 0)>(vb), h2 = tr_read<v_rd_off(D0, 2, 1)>(vb), l3 = tr_read<v_rd_off(D0, 3, 0)>(vb), h3 = tr_read<v_rd_off(D0, 3, 1)>(vb);
  asm volatile("s_waitcnt lgkmcnt(0)" ::: "memory"); SBAR();
#define PK(L, H) (bf16x8){L[0], L[1], L[2], L[3], H[0], H[1], H[2], H[3]}
  od = __builtin_amdgcn_mfma_f32_32x32x16_bf16(pa0, PK(l0, h0), od, 0, 0, 0);
  od = __builtin_amdgcn_mfma_f32_32x32x16_bf16(pa1, PK(l1, h1), od, 0, 0, 0);
  od = __builtin_amdgcn_mfma_f32_32x32x16_bf16(pa2, PK(l2, h2), od, 0, 0, 0);
  od = __builtin_amdgcn_mfma_f32_32x32x16_bf16(pa3, PK(l3, h3), od, 0, 0, 0);
#undef PK
}
__device__ __forceinline__ void pv_d0(f32x16* o, int vb, bf16x8 pa0, bf16x8 pa1, bf16x8 pa2, bf16x8 pa3) {
  pv_one<0>(o[0], vb, pa0, pa1, pa2, pa3); pv_one<1>(o[1], vb, pa0, pa1, pa2, pa3); pv_one<2>(o[2], vb, pa0, pa1, pa2, pa3); pv_one<3>(o[3], vb, pa0, pa1, pa2, pa3);
}
__device__ __forceinline__ void attn_dense_body(const bf16_t* __restrict__ Qb, const bf16_t* __restrict__ Kh, const bf16_t* __restrict__ Vh,
                                                bf16_t* __restrict__ Ob, const bf16_t* __restrict__ Zb, int seq, char* lds) {
  constexpr int SDEPTH = 2;
  int tid_ = threadIdx.x; asm volatile("" : "+v"(tid_)); const int tid = tid_, wid = tid >> 6, lane = tid & 63, r32 = lane & 31, hi = lane >> 5;
  bf16_t* V_lds = (bf16_t*)lds; bf16_t* K_lds = (bf16_t*)(lds + 2 * SHM_V);
  float* ws = (float*)(lds + 2 * SHM_V + 2 * SHM_K) + wid * 64; float* li_l = ws; float* al_l = ws + 32;
  float m_reg = -1e30f, l_reg = 0; f32x16 o[4] = {}; bf16x8 qr[8];
  const bf16_t* Qw = Qb + (long)(wid * QBLK + r32) * LDQ + hi * 8;
#pragma unroll
  for (int d0 = 0; d0 < 8; ++d0) qr[d0] = *reinterpret_cast<const bf16x8*>(Qw + d0 * 16);
  const int sr = tid >> 4, sc = (tid & 15) * 8, vst0 = v_st(sr, sc), vst1 = v_st(32 + sr, sc);
  const int vb0 = (int)(uintptr_t)V_lds + v_rd_base(lane);
  struct { bf16x8 vs0, vs1, ks0, ks1; } sr_[SDEPTH];
#define SLOAD(i, k0) do { sr_[i].vs0 = *reinterpret_cast<const bf16x8*>(&Vh[(long)((k0) + sr) * LDK + sc]); sr_[i].vs1 = *reinterpret_cast<const bf16x8*>(&Vh[(long)((k0) + 32 + sr) * LDK + sc]); \
    sr_[i].ks0 = *reinterpret_cast<const bf16x8*>(&Kh[(long)((k0) + sr) * LDK + sc]); sr_[i].ks1 = *reinterpret_cast<const bf16x8*>(&Kh[(long)((k0) + 32 + sr) * LDK + sc]); } while (0)
#define SWRITE(b, i) do { *(bf16x8*)((char*)V_lds + (b) * SHM_V + vst0) = sr_[i].vs0;          \
    *(bf16x8*)((char*)V_lds + (b) * SHM_V + vst1) = sr_[i].vs1; int kc = sc * 2;               \
    *(bf16x8*)((char*)K_lds + (b) * SHM_K + KSWZ(sr, kc)) = sr_[i].ks0;                       \
    *(bf16x8*)((char*)K_lds + (b) * SHM_K + KSWZ(32 + sr, kc)) = sr_[i].ks1; } while (0)
#define SWAIT() do { asm volatile("s_waitcnt vmcnt(4)" ::: "memory"); } while (0)
#define RESC(a) do { if (__any((a) < 1.f)) { if (hi == 0) al_l[r32] = (a); asm volatile("s_waitcnt lgkmcnt(0)" ::: "memory"); \
    for (int d = 0; d < 4; ++d) for (int r = 0; r < 16; ++r) o[d][r] *= al_l[crow(r, hi)]; } } while (0)
  f32x16 pA0, pA1, pB0, pB1; float mnA, mnB, alA, alB; bf16x8 pa0, pa1, pa2, pa3; const int NT = seq / KVBLK;
  constexpr int SE = 0, SO = SDEPTH - 1;
  SLOAD(SE, 0); asm volatile("s_waitcnt vmcnt(0)" ::: "memory"); SWRITE(0, SE); __syncthreads();
  qkt(pA0, pA1, K_lds, qr, r32, hi); partialSM(pA0, pA1, m_reg, mnA, alA);
  SLOAD(SO, KVBLK); if (2 < NT) SLOAD(SE, 2 * KVBLK);
  SWAIT(); SWRITE(1, SO); __syncthreads();
  for (int j = 1; j + 1 < NT; j += 2) {
    SBAR(); qkt(pB0, pB1, (bf16_t*)((char*)K_lds + SHM_K), qr, r32, hi);
    finishSM(pA0, pA1, alA, l_reg, pa0, pa1, pa2, pa3); SBAR();
    SLOAD(SO, (j + SDEPTH) * KVBLK); SBAR();
    pv_d0(o, vb0, pa0, pa1, pa2, pa3); partialSM(pB0, pB1, m_reg, mnB, alB);
    __syncthreads(); SWAIT(); SWRITE(0, SE);
    RESC(alB); __syncthreads();
    SBAR(); qkt(pA0, pA1, K_lds, qr, r32, hi);
    finishSM(pB0, pB1, alB, l_reg, pa0, pa1, pa2, pa3); SBAR();
    if (j + 3 < NT) SLOAD(SE, (j + 1 + SDEPTH) * KVBLK); SBAR();
    pv_d0(o, vb0 + (int)SHM_V, pa0, pa1, pa2, pa3); partialSM(pA0, pA1, m_reg, mnA, alA);
    __syncthreads(); SWAIT(); SWRITE(1, SO);
    RESC(alA); __syncthreads();
  }
  SBAR(); qkt(pB0, pB1, (bf16_t*)((char*)K_lds + SHM_K), qr, r32, hi);
  finishSM(pA0, pA1, alA, l_reg, pa0, pa1, pa2, pa3); SBAR();
  pv_d0(o, vb0, pa0, pa1, pa2, pa3); partialSM(pB0, pB1, m_reg, mnB, alB);
  __syncthreads(); RESC(alB);
  finishSM(pB0, pB1, alB, l_reg, pa0, pa1, pa2, pa3); SBAR();
  pv_d0(o, vb0 + (int)SHM_V, pa0, pa1, pa2, pa3);
  if (hi == 0) li_l[r32] = l_reg; asm volatile("s_waitcnt lgkmcnt(0)" ::: "memory");
  float rli[16];
#pragma unroll
  for (int r = 0; r < 16; ++r) rli[r] = __builtin_amdgcn_rcpf(li_l[crow(r, hi)]);
  bf16_t* Ow = Ob + (long)(wid * QBLK) * 1024;
  const bf16_t* Zw = Zb + (long)(wid * QBLK) * LDP;
#pragma unroll
  for (int r = 0; r < 16; ++r) { int orow = crow(r, hi);
    for (int d0 = 0; d0 < 4; ++d0) Ow[(long)orow * 1024 + d0 * 32 + r32] = f2bf(o[d0][r] * rli[r] * bf2f(Zw[(long)orow * LDP + d0 * 32 + r32])); }
  __syncthreads();
#undef SLOAD
#undef SWRITE
#undef SWAIT
#undef RESC
}
__device__ __forceinline__ void attn_item(const Params& p, int a) {
  const bf16_t* proj = (const bf16_t*)(p.ws + WS_PROJ);
  const bf16_t* kbuf = (const bf16_t*)(p.ws + WS_KBUF); const bf16_t* vbuf = (const bf16_t*)(p.ws + WS_VBUF);
  bf16_t* UB = (bf16_t*)(p.ws + WS_UB);
  int bl, h, row0, k0, seq;
  if (a < 256) { bl = a >> 7; h = (a >> 4) & 7; row0 = bl * SEQ + (a & 15) * 256; k0 = 0; seq = SKV; }
  else { const int i = a - 256; bl = i >> 3; h = i & 7; row0 = NLAT + bl * CTXL; k0 = SEQ; seq = CTXL; }
  const size_t kvo = ((size_t)(bl * 2 + (h >> 2)) * SKV + k0) * 128;
  attn_dense_body(proj + (size_t)row0 * LDP + PC_Q + h * 128, kbuf + kvo, vbuf + kvo, UB + (size_t)row0 * 1024 + h * 128,
                  proj + (size_t)row0 * LDP + PC_ZA + h * 128, seq, smem);
}

constexpr int GQS = 136, GTS = 72, GDV = 32;
constexpr int G_QS = 0, G_KS = 64 * GQS, G_KST = 2 * 64 * GQS, G_VST = G_KST + 128 * GTS, G_STAGE = G_VST + GDV * GTS;
constexpr int G_AS = 2 * G_STAGE, G_STS = G_AS + 64 * GTS, G_END = G_STS + GDV * GQS;
static_assert(G_END * 2 <= SMEM_MAIN, "GLA LDS");
__device__ __forceinline__ void gla_item(const Params& p, int item) {
  int tid_ = threadIdx.x; asm volatile("" : "+v"(tid_)); const int tid = tid_, w = tid >> 6, lane = tid & 63, lr = lane & 15, lq = lane >> 4;
  const int dvs = item & 7, dir = (item >> 3) & 1, head = (item >> 4) & 3, bl = item >> 6;
  const bf16_t* QT = (const bf16_t*)(p.ws + WS_QT) + (size_t)dir * GROWS * 512 + head * 128;
  const bf16_t* KT = (const bf16_t*)(p.ws + WS_KT) + (size_t)dir * GROWS * 512 + head * 128;
  const bf16_t* KTT = (const bf16_t*)(p.ws + WS_KTT) + ((size_t)dir * 136 * 512 + head * 128) * 64;
  const bf16_t* VT = (const bf16_t*)(p.ws + WS_VT) + (size_t)(head * 256 + dvs * GDV) * GROWS;
  const float* E = (const float*)(p.ws + WS_E) + (size_t)dir * 136 * 512 + head * 128 + w * 16 + lq * 4;
  bf16_t* OG = (bf16_t*)(p.ws + WS_OG) + (size_t)dir * GROWS * 1024 + head * 256 + dvs * GDV;
  bf16_t* L = (bf16_t*)smem;
  bf16_t* As = L + G_AS; bf16_t* STs = L + G_STS;
  const int srow = tid >> 3, scol = (tid & 7) * 16, vcol = (tid & 7) * 8, trow = tid >> 2, tcol = (tid & 3) * 16;
  const bool vld = tid < 256;
  f32x4 S[2];
#pragma unroll
  for (int i = 0; i < 2; ++i) S[i] = f32x4{0.f, 0.f, 0.f, 0.f};
  for (int i = tid; i < GDV * GQS / 2; i += 512) ((unsigned*)STs)[i] = 0u;
  struct Regs { u32x4 q0, q1, k0, k1, t0, t1, v0; };
  Regs RA, RB; f32x4 eA, eB;
  RA.v0 = u32x4{0u, 0u, 0u, 0u}; RB.v0 = RA.v0;
  auto chunk_row0 = [&](int c) -> int {
    if (c < 4) { const int cc = dir ? 3 - c : c; return NLAT + bl * CTXL + cc * 64; }
    const int cc = dir ? 63 - (c - 4) : (c - 4); return bl * SEQ + cc * 64;
  };
  auto gload = [&](int c, Regs& r) {
    const int r0_ = chunk_row0(c); const size_t r_ = (size_t)(r0_ + srow);
    r.q0 = *reinterpret_cast<const u32x4*>(QT + r_ * 512 + scol); r.q1 = *reinterpret_cast<const u32x4*>(QT + r_ * 512 + scol + 8);
    r.k0 = *reinterpret_cast<const u32x4*>(KT + r_ * 512 + scol); r.k1 = *reinterpret_cast<const u32x4*>(KT + r_ * 512 + scol + 8);
    const bf16_t* tp_ = KTT + ((size_t)(r0_ >> 6) * 512 + trow) * 64 + tcol;
    r.t0 = *reinterpret_cast<const u32x4*>(tp_); r.t1 = *reinterpret_cast<const u32x4*>(tp_ + 8);
    if (vld) r.v0 = *reinterpret_cast<const u32x4*>(VT + (size_t)srow * GROWS + r0_ + vcol);
  };
  auto gstore = [&](int bsel, const Regs& r) {
    bf16_t* b_ = L + bsel * G_STAGE;
    *reinterpret_cast<u32x4*>(b_ + G_QS + srow * GQS + scol) = r.q0; *reinterpret_cast<u32x4*>(b_ + G_QS + srow * GQS + scol + 8) = r.q1;
    *reinterpret_cast<u32x4*>(b_ + G_KS + srow * GQS + scol) = r.k0; *reinterpret_cast<u32x4*>(b_ + G_KS + srow * GQS + scol + 8) = r.k1;
    *reinterpret_cast<u32x4*>(b_ + G_KST + trow * GTS + tcol) = r.t0; *reinterpret_cast<u32x4*>(b_ + G_KST + trow * GTS + tcol + 8) = r.t1;
    if (vld) *reinterpret_cast<u32x4*>(b_ + G_VST + srow * GTS + vcol) = r.v0;
  };
  auto eload = [&](int c) -> f32x4 { return *reinterpret_cast<const f32x4*>(E + (size_t)(chunk_row0(c) >> 6) * 512); };
  gload(0, RA); gstore(0, RA); gload(1, RA); gload(2, RB);
  eA = eload(0); eB = eA;
  __syncthreads();
  const int tr = w >> 1, tc0 = (w & 1) * 2, tco = w & 1;
  auto step = [&](int c, Regs& RX, const f32x4& eCur, f32x4& eNext) {
    const int row0 = chunk_row0(c);
    const bf16_t* B = L + (c & 1) * G_STAGE;
    bf16x8 qf[4];
    gstore((c + 1) & 1, RX);
    gload(c + 3 < 68 ? c + 3 : 67, RX);
    eNext = eload(c + 1 < 68 ? c + 1 : 67);
    {
      f32x4 a0 = {0.f, 0.f, 0.f, 0.f}, a1 = {0.f, 0.f, 0.f, 0.f};
#pragma unroll
      for (int kk = 0; kk < 4; ++kk) {
        qf[kk] = *reinterpret_cast<const bf16x8*>(B + G_QS + (tr * 16 + lr) * GQS + kk * 32 + lq * 8);
        const bf16x8 b0 = *reinterpret_cast<const bf16x8*>(B + G_KS + (tc0 * 16 + lr) * GQS + kk * 32 + lq * 8);
        const bf16x8 b1 = *reinterpret_cast<const bf16x8*>(B + G_KS + ((tc0 + 1) * 16 + lr) * GQS + kk * 32 + lq * 8);
        a0 = __builtin_amdgcn_mfma_f32_16x16x32_bf16(b0, qf[kk], a0, 0, 0, 0);
        a1 = __builtin_amdgcn_mfma_f32_16x16x32_bf16(b1, qf[kk], a1, 0, 0, 0);
      }
      const int t = tr * 16 + lr;
#pragma unroll
      for (int j = 0; j < 4; ++j) {
        const int s0 = tc0 * 16 + lq * 4 + j, s1 = s0 + 16;
        const bool m0 = dir ? (s0 >= t) : (s0 <= t), m1 = dir ? (s1 >= t) : (s1 <= t);
        a0[j] = m0 ? a0[j] : 0.f; a1[j] = m1 ? a1[j] : 0.f;
      }
      u32x2 w0 = {cvtpk(a0[0], a0[1]), cvtpk(a0[2], a0[3])}, w1 = {cvtpk(a1[0], a1[1]), cvtpk(a1[2], a1[3])};
      *reinterpret_cast<u32x2*>(As + t * GTS + tc0 * 16 + lq * 4) = w0;
      *reinterpret_cast<u32x2*>(As + t * GTS + (tc0 + 1) * 16 + lq * 4) = w1;
    }
    __syncthreads();
    {
      f32x4 o0 = {0.f, 0.f, 0.f, 0.f};
#pragma unroll
      for (int kk = 0; kk < 2; ++kk) {
        const bf16x8 af = *reinterpret_cast<const bf16x8*>(As + (tr * 16 + lr) * GTS + kk * 32 + lq * 8);
        const bf16x8 b0 = *reinterpret_cast<const bf16x8*>(B + G_VST + (tco * 16 + lr) * GTS + kk * 32 + lq * 8);
        o0 = __builtin_amdgcn_mfma_f32_16x16x32_bf16(b0, af, o0, 0, 0, 0);
      }
#pragma unroll
      for (int kk = 0; kk < 4; ++kk) {
        const bf16x8 b0 = *reinterpret_cast<const bf16x8*>(STs + (tco * 16 + lr) * GQS + kk * 32 + lq * 8);
        o0 = __builtin_amdgcn_mfma_f32_16x16x32_bf16(b0, qf[kk], o0, 0, 0, 0);
      }
      {
        bf16_t* op = OG + (size_t)(row0 + tr * 16 + lr) * 1024 + tco * 16 + lq * 4;
        u32x2 w0 = {cvtpk(o0[0], o0[1]), cvtpk(o0[2], o0[3])};
        *reinterpret_cast<u32x2*>(op) = w0;
      }
#pragma unroll
      for (int kk = 0; kk < 2; ++kk) {
        const bf16x8 af = *reinterpret_cast<const bf16x8*>(B + G_KST + (w * 16 + lr) * GTS + kk * 32 + lq * 8);
#pragma unroll
        for (int tc = 0; tc < 2; ++tc) {
          const bf16x8 bfr = *reinterpret_cast<const bf16x8*>(B + G_VST + (tc * 16 + lr) * GTS + kk * 32 + lq * 8);
          S[tc] = __builtin_amdgcn_mfma_f32_16x16x32_bf16(af, bfr, S[tc], 0, 0, 0);
        }
      }
#pragma unroll
      for (int tc = 0; tc < 2; ++tc) S[tc] *= eCur;
    }
    __syncthreads();
#pragma unroll
    for (int tc = 0; tc < 2; ++tc) {
      u32x2 wv = {cvtpk(S[tc][0], S[tc][1]), cvtpk(S[tc][2], S[tc][3])};
      *reinterpret_cast<u32x2*>(STs + (tc * 16 + lr) * GQS + w * 16 + lq * 4) = wv;
    }
  };
#pragma unroll 1
  for (int c = 0; c < 68; c += 2) { step(c, RA, eA, eB); step(c + 1, RB, eB, eA); }
  __syncthreads();
}

__device__ __forceinline__ void glapost_rows(const Params& p, int l) {
  int tid_ = threadIdx.x; asm volatile("" : "+v"(tid_)); const int tid = tid_, wave = tid >> 6, lane = tid & 63;
  const bf16_t* OG0 = (const bf16_t*)(p.ws + WS_OG); const bf16_t* OG1 = OG0 + (size_t)GROWS * 1024;
  const bf16_t* proj = (const bf16_t*)(p.ws + WS_PROJ);
  bf16_t* UC = (bf16_t*)(p.ws + WS_UC);
  const int nrows = l == 0 ? GROWS : NLAT;
  const float* gg = p.gla_g + l * 256 + (lane & 15) * 16;
  const int ntile = (nrows / 256) * 4, nrb = (int)gridDim.x - ntile;
  for (int row = ((int)blockIdx.x - ntile) * 8 + wave; row < nrows; row += nrb * 8) {
    const size_t o = (size_t)row * 1024 + lane * 16;
    float v[16]; float ss = 0.f;
#pragma unroll
    for (int i = 0; i < 2; ++i) {
      const u32x4 a = *reinterpret_cast<const u32x4*>(OG0 + o + i * 8), b = *reinterpret_cast<const u32x4*>(OG1 + o + i * 8);
#pragma unroll
      for (int q = 0; q < 4; ++q) { v[i * 8 + 2 * q] = bflo(a[q]) + bflo(b[q]); v[i * 8 + 2 * q + 1] = bfhi(a[q]) + bfhi(b[q]); }
    }
#pragma unroll
    for (int i = 0; i < 16; ++i) ss += v[i] * v[i];
#pragma unroll
    for (int s = 8; s >= 1; s >>= 1) ss += __shfl_xor(ss, s, 64);
    const float rs = rsqrtf(ss * (1.f / 256.f) + EPS);
#pragma unroll
    for (int i = 0; i < 2; ++i) {
      const u32x4 z = *reinterpret_cast<const u32x4*>(proj + (size_t)row * LDP + PC_ZG + lane * 16 + i * 8);
      float r[8];
#pragma unroll
      for (int q = 0; q < 4; ++q) {
        r[2 * q] = v[i * 8 + 2 * q] * rs * gg[i * 8 + 2 * q] * bflo(z[q]);
        r[2 * q + 1] = v[i * 8 + 2 * q + 1] * rs * gg[i * 8 + 2 * q + 1] * bfhi(z[q]);
      }
      u32x4 wv = {cvtpk(r[0], r[1]), cvtpk(r[2], r[3]), cvtpk(r[4], r[5]), cvtpk(r[6], r[7])};
      *reinterpret_cast<u32x4*>(UC + o + i * 8) = wv;
    }
  }
}

__device__ __forceinline__ void merge_tile(const Params& p, int l, int pm, int pn, int br) {
  EpiMerge epi; epi.gate = (const bf16_t*)(p.ws + WS_PROJ) + PC_MG + br * 1024;
  epi.M = (bf16_t*)(p.ws + WS_M); epi.br = br;
  const bf16_t* Ab = (const bf16_t*)(p.ws + (br == 0 ? WS_UA : (br == 1 ? WS_UB : WS_UC)));
  const bf16_t* W = (const bf16_t*)(p.ws + WS_WTBR) + (size_t)(l * 3 + br) * 1024 * 1024;
  gemm_tile(Ab, W, 1024, pm * 256, pn * 256, epi);
}
__device__ __forceinline__ void merge_phase(const Params& p, int l) {
  const int nM = (l == 0 ? GROWS : NLAT) / 256, nN = 4;
  for (int i = 0;; ++i) {
    int pm, pn; if (!tile_of(i * gridDim.x + blockIdx.x, nM, nN, pm, pn)) break;
#pragma unroll 1
    for (int br = 2; br < 3; ++br) merge_tile(p, l, pm, pn, br);
  }
}
__device__ __forceinline__ void out_phase(const Params& p, int l) {
  const bf16_t* M = (const bf16_t*)(p.ws + WS_M);
  const bf16_t* W = (const bf16_t*)(p.ws + WS_WTOUT) + (size_t)l * 1024 * 1024;
  EpiOutF epi; epi.O = (bf16_t*)(p.ws + WS_OUTF);
  const int nM = (l == 0 ? GROWS : NLAT) / 256, nN = 4;
  for (int i = 0;; ++i) {
    int pm, pn; if (!tile_of(i * gridDim.x + blockIdx.x, nM, nN, pm, pn)) break;
    gemm_tile(M, W, 1024, pm * 256, pn * 256, epi);
  }
}


#ifndef DBG_STOP
#define DBG_STOP 0
#define DBG_WHICH 4
#endif
__device__ __forceinline__ void dbg_dump(const Params& p, int which) {
  const size_t n_out = (size_t)NB * SEQ * DM;
  const size_t gtid = (size_t)blockIdx.x * 512 + threadIdx.x, gsz = (size_t)gridDim.x * 512;
  if (which == 1) {
    const bf16_t* UB = (const bf16_t*)(p.ws + WS_UB); const bf16_t* OG = (const bf16_t*)(p.ws + WS_OG);
    const size_t n1 = (size_t)GROWS * 1024, n2 = (size_t)2 * GROWS * 1024;
    for (size_t i = gtid; i < n_out; i += gsz) {
      float v = 0.f;
      if (i < n1) v = bf2f(UB[i]);
      p.out[i] = v;
    }
  } else if (which == 4) {
    const bf16_t* QT = (const bf16_t*)(p.ws + WS_QT); const bf16_t* KT = (const bf16_t*)(p.ws + WS_KT); const float* E = (const float*)(p.ws + WS_E);
    const size_t n1 = (size_t)2 * GROWS * 512, n2 = (size_t)GROWS * 512 + 200000, n3 = (size_t)2 * 136 * 512;
    for (size_t i = gtid; i < n_out; i += gsz) {
      float v = 0.f;
      if (i < n1) v = bf2f(QT[i]); else if (i < n1 + n2) v = bf2f(KT[i - n1]); else if (i < n1 + n2 + n3) v = E[i - n1 - n2];
      p.out[i] = v;
    }
  } else if (which == 2) {
    const bf16_t* proj = (const bf16_t*)(p.ws + WS_PROJ);
    const size_t n1 = (size_t)3000 * LDP;
    for (size_t i = gtid; i < n_out; i += gsz) p.out[i] = i < n1 ? bf2f(proj[i]) : 0.f;
  } else {
    const bf16_t* outf = (const bf16_t*)(p.ws + WS_OUTF);
    const size_t n1 = (size_t)GROWS * 1024;
    for (size_t i = gtid; i < n_out; i += gsz) p.out[i] = i < n1 ? outf[i] : 0.f;
  }
}


#define XB_TMO      128
#define XB_XCNT(j)  (256  + 64 * (j))
#define XB_XSUB(j)  (1280 + 64 * (j))
#define XB_XGEN(j)  (2304 + 64 * (j))
#define XB_TOP      3328
#define XB_TOPGEN   3392
#define XCD_BAR_WORDS 3456
#define XB_SPIN_CAP (1u << 18)
__device__ __forceinline__ unsigned xb_ld(unsigned* p)              { return __hip_atomic_load(p, __ATOMIC_RELAXED, __HIP_MEMORY_SCOPE_AGENT); }
__device__ __forceinline__ unsigned xb_add(unsigned* p, unsigned v) { return __hip_atomic_fetch_add(p, v, __ATOMIC_RELAXED, __HIP_MEMORY_SCOPE_AGENT); }
__device__ __forceinline__ unsigned xb_xcc_id() { return (unsigned)__builtin_amdgcn_s_getreg((3 << 11) | 20) & 0xFu; }
#define XB_SPIN(cond, bar) do { unsigned _sp = 0; while (cond) { __builtin_amdgcn_s_sleep(1); \
    if ((++_sp & 255u) == 0u) { if (xb_ld(&(bar)[XB_TMO])) break; if (_sp > XB_SPIN_CAP) { atomicAdd(&(bar)[XB_TMO], 1u); break; } } } } while (0)
struct XcdBarrier { unsigned* bar; unsigned x; volatile LAS unsigned* st; };
__device__ __forceinline__ XcdBarrier xcd_barrier_post(unsigned* bar, volatile LAS unsigned* st) {
  XcdBarrier b; b.bar = bar; b.x = xb_xcc_id(); b.st = st;
  if (threadIdx.x == 0) (void)xb_add(&bar[XB_XCNT(b.x)], 1u);
  return b;
}
__device__ __forceinline__ void xcd_barrier_complete(unsigned* bar, unsigned x, unsigned& nloc, unsigned& nx) {
  const unsigned G = gridDim.x * gridDim.y * gridDim.z;
  unsigned sum, cnt, mine, sp = 0u;
  for (;;) {
    sum = 0u; cnt = 0u; mine = 0u;
#pragma unroll
    for (unsigned j = 0; j < 16; ++j) { const unsigned c = xb_ld(&bar[XB_XCNT(j)]); sum += c; cnt += (c > 0u) ? 1u : 0u; mine = (j == x) ? c : mine; }
    if (sum == G) break;
    __builtin_amdgcn_s_sleep(1);
    if ((++sp & 255u) == 0u) { if (xb_ld(&bar[XB_TMO])) break; if (sp > XB_SPIN_CAP) { atomicAdd(&bar[XB_TMO], 1u); break; } }
  }
  nloc = mine > 0u ? mine : 1u; nx = cnt > 0u ? cnt : 1u;
}
__device__ __forceinline__ void xcd_barrier(const XcdBarrier& b) {
  asm volatile("s_waitcnt vmcnt(0)" ::: "memory");
  __syncthreads();
  if (threadIdx.x == 0) {
    unsigned* bar = b.bar;
    __builtin_amdgcn_s_waitcnt(0);
    unsigned nloc = b.st[0], nx = b.st[1];
    if (nloc == 0u) { xcd_barrier_complete(bar, b.x, nloc, nx); b.st[0] = nloc; b.st[1] = nx; }
    const unsigned old = xb_add(&bar[XB_XSUB(b.x)], 1u);
    const unsigned gen = old / nloc;
    if (old + 1u == (gen + 1u) * nloc) {
      __builtin_amdgcn_fence(__ATOMIC_RELEASE, "agent");
      asm volatile("s_waitcnt vmcnt(0)" ::: "memory");
      const unsigned og = xb_add(&bar[XB_TOP], 1u);
      const unsigned tg = og / nx;
      if (og + 1u == (tg + 1u) * nx) xb_add(&bar[XB_TOPGEN], 1u);
      else XB_SPIN(xb_ld(&bar[XB_TOPGEN]) == tg, bar);
      __builtin_amdgcn_fence(__ATOMIC_ACQUIRE, "agent");
      xb_add(&bar[XB_XGEN(b.x)], 1u);
      asm volatile("s_waitcnt vmcnt(0)" ::: "memory");
    } else {
      XB_SPIN(xb_ld(&bar[XB_XGEN(b.x)]) == gen, bar);
      __builtin_amdgcn_fence(__ATOMIC_ACQUIRE, "agent");
      asm volatile("s_waitcnt vmcnt(0)" ::: "memory");
    }
  }
  __syncthreads();
}

__device__ __forceinline__ void glapost_phase(const Params& p, int l) {
  const int nM = (l == 0 ? GROWS : NLAT) / 256, ntile = nM * 4;
  if ((int)blockIdx.x < ntile) { int pm, pn; tile_of(blockIdx.x, nM, 4, pm, pn); merge_tile(p, l, pm, pn, 1); }
  else glapost_rows(p, l);
}
__device__ __forceinline__ void mix_phase(const Params& p, int l) {
  const int natt = (l == 0) ? 272 : 256;
  const int nM = (l == 0 ? GROWS : NLAT) / 256, nmerge = nM * 4, nctx = natt - 256, ndef = nM * (l == 0 ? 6 : 4), nextra = nmerge + nctx + ndef;
  const int b = blockIdx.x;
  for (int k = 0;; ++k) {
    int type, idx;
    if (b < 128) { if (k == 0) { type = 0; idx = ((((b & 7) << 1) | (b >> 6)) << 3) | ((b >> 3) & 7); } else if (k == 1) { type = 1; idx = 128 + ((((b & 1) << 2) | ((b >> 3) & 3)) << 4) + (((b & 7) >> 1) << 2) + (b >> 5); } else break; }
    else if (b < 256) {
      if (k == 0) { const int c = b - 128; type = 1; idx = ((((c & 1) << 2) | ((c >> 3) & 3)) << 4) + (((c & 7) >> 1) << 2) + (c >> 5); }
      else { const int e = (b - 128) + (k - 1) * 128; if (e >= nextra) break;
        if (e < nmerge) { type = 2; idx = e; } else if (e < nmerge + nctx) { type = 1; idx = 256 + e - nmerge; } else { type = 3; idx = e - nmerge - nctx; } }
    } else break;
    if (type == 0) gla_item(p, idx);
    else if (type == 1) attn_item(p, idx);
    else if (type == 2) { int pm, pn; tile_of(idx, nM, 4, pm, pn); merge_tile(p, l, pm, pn, 0); }
    else inproj_deferred_tile(p, l, idx, ndef);
  }
}

constexpr int NPHASE = 1 + 4 * 15;
__device__ __forceinline__ void run_phase(const Params& p, int ph) {
  if (ph == 0) { phase0(p); return; }
  const int q = ph - 1, g = q / 15, r = q % 15;
  if (r == 14) { norm_phase(p, g, 2); return; }
  if (r == 0 && g > 0) return;
  const int l = r / 7, s = r % 7;
  switch (s) {
    case 0: norm_phase(p, g, l); break;
    case 1: inproj_phase(p, l); break;
    case 2: prep_phase(p, l); break;
    case 3: mix_phase(p, l); break;
    case 4: glapost_phase(p, l); break;
    case 5: merge_phase(p, l); break;
    default: out_phase(p, l);
      if (l == 1 && g < 3 && (int)gridDim.x > 128) {
        if ((int)blockIdx.x >= 128) norm_rows(p, g + 1, 0, 0, GROWS, (int)blockIdx.x - 128, (int)gridDim.x - 128);
      } else if (l == 1 && g < 3) norm_phase(p, g + 1, 0);
      break;
  }
}

__global__ void __launch_bounds__(512) mega(Params p, int ph_lo, int ph_hi, int coop) {
  volatile LAS unsigned* st = (volatile LAS unsigned*)((LAS unsigned char*)smem + SMEM_MAIN);
  XcdBarrier xb; xb.bar = (unsigned*)(p.ws + WS_BAR); xb.x = 0; xb.st = st;
  if (coop) {
    if (threadIdx.x < 4) st[threadIdx.x] = 0u;
    __syncthreads();
    xb = xcd_barrier_post((unsigned*)(p.ws + WS_BAR), st);
  }
  for (int ph = ph_lo; ph < ph_hi; ++ph) {
    if (ph > 15 && (ph - 1) % 15 == 0) continue;
    run_phase(p, ph);
    if (coop && ph + 1 < ph_hi) {
      if (coop == 2) cg::this_grid().sync();
      else xcd_barrier(xb);
    }
  }
}

__global__ void __launch_bounds__(512) dbg_kernel(Params p, int which) { dbg_dump(p, which); }

#ifndef MULTI_LAUNCH
#define MULTI_LAUNCH 0
#endif

extern "C" void kernel_launch(void* const* d_in, const int* in_sizes, int n_in, void* d_out, int out_size, void* d_ws, size_t ws_size,
                              hipStream_t stream) {
  static int grid_blocks = 0;
  if (!grid_blocks) {
    if (ws_size < WS_END) { fprintf(stderr, "kernel_launch: workspace too small: %zu < %zu\n", ws_size, (size_t)WS_END); return; }
    if (hipFuncSetAttribute((const void*)mega, hipFuncAttributeMaxDynamicSharedMemorySize, SMEM_BYTES) != hipSuccess) {
      fprintf(stderr, "kernel_launch: hipFuncSetAttribute failed\n"); return; }
    int dev = 0, cus = 0, per_cu = 0;
    hipGetDevice(&dev);
    hipDeviceGetAttribute(&cus, hipDeviceAttributeMultiprocessorCount, dev);
    hipOccupancyMaxActiveBlocksPerMultiprocessor(&per_cu, mega, 512, SMEM_BYTES);
    if (per_cu < 1) per_cu = 1;
    grid_blocks = 256;
    if (cus < 256) { fprintf(stderr, "kernel_launch: needs 256 CUs, have %d\n", cus); grid_blocks = 0; return; }
  }
  Params p{};
  p.x = (const float*)d_in[0]; p.c = (const float*)d_in[1]; p.ctx = (const float*)d_in[2]; p.c_ctx = (const float*)d_in[3];
  p.w_ada = (const float*)d_in[4]; p.b_ada = (const float*)d_in[5]; p.g_pre = (const float*)d_in[6]; p.g_post = (const float*)d_in[7];
  p.w_in = (const float*)d_in[8]; p.conv_w = (const float*)d_in[9]; p.q_g = (const float*)d_in[10]; p.k_g = (const float*)d_in[11];
  p.w_df = (const float*)d_in[12]; p.b_df = (const float*)d_in[13]; p.w_db = (const float*)d_in[14]; p.b_db = (const float*)d_in[15];
  p.gla_g = (const float*)d_in[16]; p.w_bc = (const float*)d_in[17]; p.w_ba = (const float*)d_in[18]; p.w_bg = (const float*)d_in[19];
  p.b_gate = (const float*)d_in[20]; p.w_out = (const float*)d_in[21];
  p.out = (float*)d_out; p.ws = (char*)d_ws;
#if MULTI_LAUNCH
  for (int ph = 0; ph < (DBG_STOP ? DBG_STOP : NPHASE); ++ph) {
    hipLaunchKernelGGL(mega, dim3(grid_blocks), dim3(512), SMEM_BYTES, stream, p, ph, ph + 1, 0);
  }
  if (DBG_STOP) hipLaunchKernelGGL(dbg_kernel, dim3(grid_blocks), dim3(512), 0, stream, p, DBG_WHICH);
#else
  hipMemsetAsync((char*)d_ws + WS_BAR, 0, 16384, stream);
  int lo = 0, hi = NPHASE, coop = 1;
  void* args[] = {&p, &lo, &hi, &coop};
  hipError_t e = hipLaunchCooperativeKernel((void*)mega, dim3(grid_blocks), dim3(512), args, SMEM_BYTES, stream);
  if (e != hipSuccess) fprintf(stderr, "cooperative launch failed: %s (grid %d)\n", hipGetErrorString(e), grid_blocks);
#endif
}
```

```cpp
#include <hip/hip_runtime.h>
#include <hip/hip_bf16.h>
#include <hip/hip_cooperative_groups.h>
#include <cstdio>
#include <cstdint>
namespace cg = cooperative_groups;

typedef unsigned short bf16_t;
using bf16x8 = __attribute__((ext_vector_type(8))) short;
using s16x4  = __attribute__((ext_vector_type(4))) short;
using f32x4  = __attribute__((ext_vector_type(4))) float;
using f32x16 = __attribute__((ext_vector_type(16))) float;
using u32x4  = __attribute__((ext_vector_type(4))) unsigned;
using u32x2  = __attribute__((ext_vector_type(2))) unsigned;

constexpr int DM = 1024, NB = 8, SEQ = 4096, CTXL = 256, INW = 12832;
constexpr int GROWS = 8704;
constexpr int NLAT = 8192;
constexpr int NPAD = 13056;
constexpr int LDP = 10752;
constexpr int PC_CX = 0, PC_BZ = 1024, PC_Q = 2048, PC_K = 3072, PC_V = 3328, PC_ZA = 3584, PC_GQ = 4608, PC_GK = 5120,
              PC_GV = 5632, PC_ZG = 6656, PC_MG = 7680;
constexpr int SKV = 4352;
constexpr float EPS = 1e-6f;

constexpr size_t al256(size_t x) { return (x + 255) / 256 * 256; }
constexpr size_t WS_WTIN = 0;
constexpr size_t WS_WTBR = WS_WTIN + al256((size_t)2 * NPAD * 1024 * 2);
constexpr size_t WS_WTOUT = WS_WTBR + al256((size_t)2 * 3 * 1024 * 1024 * 2);
constexpr size_t WS_MOD = WS_WTOUT + al256((size_t)2 * 1024 * 1024 * 2);
constexpr size_t WS_H = WS_MOD + al256((size_t)2 * 9 * 3072 * 4);
constexpr size_t WS_PROJ = WS_H + al256((size_t)GROWS * 1024 * 2);
constexpr size_t WS_R = WS_PROJ + al256((size_t)GROWS * LDP * 2);
constexpr size_t WS_KBUF = WS_R + al256((size_t)GROWS * 32 * 4);
constexpr size_t WS_VBUF = WS_KBUF + al256((size_t)4 * SKV * 128 * 2);
constexpr size_t WS_QT = WS_VBUF + al256((size_t)4 * SKV * 128 * 2);
constexpr size_t WS_KT = WS_QT + al256((size_t)2 * GROWS * 512 * 2);
constexpr size_t WS_KTT = WS_KT + al256((size_t)2 * GROWS * 512 * 2);
constexpr size_t WS_VT = WS_KTT + al256((size_t)2 * GROWS * 512 * 2);
constexpr size_t WS_E = WS_VT + al256((size_t)1024 * GROWS * 2);
constexpr size_t WS_OG = WS_E + al256((size_t)2 * 136 * 512 * 4);
constexpr size_t WS_UA = WS_OG + al256((size_t)2 * GROWS * 1024 * 2);
constexpr size_t WS_UB = WS_UA + al256((size_t)GROWS * 1024 * 2);
constexpr size_t WS_UC = WS_UB + al256((size_t)GROWS * 1024 * 2);
constexpr size_t WS_M = WS_UC + al256((size_t)GROWS * 1024 * 2);
constexpr size_t WS_OUTF = WS_M + al256((size_t)GROWS * 1024 * 2);
constexpr size_t WS_MF = WS_OUTF;
constexpr size_t WS_BAR = WS_OUTF + al256((size_t)GROWS * 1024 * 4);
constexpr size_t WS_END = WS_BAR + 16384;
static_assert(WS_END <= (size_t)512 * 1024 * 1024, "workspace must fit 512 MiB");

struct Params {
  const float *x, *c, *ctx, *c_ctx, *w_ada, *b_ada, *g_pre, *g_post, *w_in, *conv_w, *q_g, *k_g, *w_df, *b_df, *w_db, *b_db,
      *gla_g, *w_bc, *w_ba, *w_bg, *b_gate, *w_out;
  float* out;
  char* ws;
};

extern __shared__ __attribute__((aligned(16))) char smem[];
constexpr int SMEM_MAIN = 151552;
constexpr int SMEM_BYTES = SMEM_MAIN + 256;

typedef __bf16 bf16v2_t __attribute__((ext_vector_type(2)));
typedef float f32v2_t __attribute__((ext_vector_type(2)));
__device__ __forceinline__ unsigned cvtpk(float lo, float hi) {
  f32v2_t f = {lo, hi};
  bf16v2_t b = __builtin_convertvector(f, bf16v2_t);
  return __builtin_bit_cast(unsigned, b);
}
__device__ __forceinline__ bf16_t f2bf(float x) { return (bf16_t)(cvtpk(x, 0.f) & 0xffffu); }
__device__ __forceinline__ float bf2f(bf16_t b) { return __uint_as_float(((unsigned)b) << 16); }
__device__ __forceinline__ float bflo(unsigned w) { return __uint_as_float(w << 16); }
__device__ __forceinline__ float bfhi(unsigned w) { return __uint_as_float(w & 0xffff0000u); }
__device__ __forceinline__ float wave_sum(float v) {
#pragma unroll
  for (int o = 32; o >= 1; o >>= 1) v += __shfl_xor(v, o, 64);
  return v;
}
__device__ __forceinline__ float silu_f(float x) { return x * __builtin_amdgcn_rcpf(1.f + __expf(-x)); }
__device__ __forceinline__ float sigmoid_f(float x) { return __builtin_amdgcn_rcpf(1.f + __expf(-x)); }

constexpr int BM = 256, BK = 64, HALF = 128, NXCD = 8, WGM = 8, HT = HALF * BK;
__device__ __forceinline__ int lds_byte(int r, int c) {
  int st = (r >> 4) * 2 + (c >> 5), rr = r & 15, cc = c & 31, ob = rr * 64 + cc * 2;
  return st * 1024 + (ob ^ (((ob >> 9) & 1) << 5));
}
__device__ __forceinline__ void stage_rc(int b, int& R, int& C) {
  int st = b / 1024, sb = b % 1024, swz = sb ^ (((sb >> 9) & 1) << 5);
  R = (st >> 1) * 16 + swz / 64; C = (st & 1) * 32 + (swz % 64) / 2;
}
__device__ __forceinline__ bool tile_of(int L, int nM, int nN, int& pm, int& pn) {
  const int nwg = nM * nN; if (L >= nwg) return false;
  int wgid = L; { const int q = nwg / NXCD, r = nwg % NXCD, xcd = wgid % NXCD, off = wgid / NXCD; wgid = (xcd < r ? xcd * (q + 1) : r * (q + 1) + (xcd - r) * q) + off; }
  const int nig = WGM * nN, gid = wgid / nig, fm = gid * WGM, gsz = (nM - fm) < WGM ? (nM - fm) : WGM;
  pm = fm + ((wgid % nig) % gsz); pn = (wgid % nig) / gsz; return true;
}

#define LAS __attribute__((address_space(3)))
constexpr int HTB = HALF * BK * 2;
template <class Epi, bool PERMB = false>
__device__ __forceinline__ void gemm_tile(const bf16_t* __restrict__ A, const bf16_t* __restrict__ Bt, const int K, const int brow,
                                          const int bcol, const Epi& epi) {
  LAS unsigned char* lds = (LAS unsigned char*)smem;
  int tid = threadIdx.x; asm volatile("" : "+v"(tid));
  const int wid = __builtin_amdgcn_readfirstlane(tid >> 6), lane = tid & 63, wr = wid >> 2, wc = wid & 3, fr = lane & 15, fq = lane >> 4;
  unsigned voff[2], voffb[2];
#pragma unroll
  for (int i = 0; i < 2; ++i) { int R, C; stage_rc(tid * 16 + i * 8192, R, C); voff[i] = (unsigned)(R * K + C) * 2u;
    const int rho = R & 31, ii = rho & 15, Rb = PERMB ? ((R & ~31) + 8 * (ii >> 2) + 4 * (rho >> 4) + (ii & 3)) : R;
    voffb[i] = (unsigned)(Rb * K + C) * 2u; }
  const size_t kstep = (size_t)(BK * 2), hstep = (size_t)HALF * K * 2;
  const unsigned ldsw = (unsigned)wid * 1024u;
  const int aoff = lds_byte(wr * 64 + fr, fq * 8), boff = lds_byte(wc * 32 + fr, fq * 8);
  const char* cA = (const char*)A + (size_t)brow * K * 2; const char* cB = (const char*)Bt + (size_t)bcol * K * 2;
#define SA(b, h) (((b) * 2 + (h)) * HTB)
#define SB(b, h) ((4 + (b) * 2 + (h)) * HTB)
#define STAGE(bufoff, gbase) do { _Pragma("unroll") for (int _i = 0; _i < 2; ++_i) \
    __builtin_amdgcn_global_load_lds((const unsigned*)((const char*)(gbase) + voff[_i]), (LAS unsigned*)(lds + (bufoff) + ldsw + _i * 8192), 16, 0, 0); } while (0)
#define STAGEB(bufoff, gbase) do { _Pragma("unroll") for (int _i = 0; _i < 2; ++_i) \
    __builtin_amdgcn_global_load_lds((const unsigned*)((const char*)(gbase) + voffb[_i]), (LAS unsigned*)(lds + (bufoff) + ldsw + _i * 8192), 16, 0, 0); } while (0)
#define LDA(dst, b, h) do { _Pragma("unroll") for (int m = 0; m < 4; ++m) _Pragma("unroll") for (int k = 0; k < 2; ++k) dst[m][k] = *(const LAS bf16x8*)(lds + SA(b, h) + aoff + m * 2048 + k * 1024); } while (0)
#define LDB(dst, b, h) do { _Pragma("unroll") for (int n = 0; n < 2; ++n) _Pragma("unroll") for (int k = 0; k < 2; ++k) dst[n][k] = *(const LAS bf16x8*)(lds + SB(b, h) + boff + n * 2048 + k * 1024); } while (0)
#define MMA(ai, bj, At_, Bt_) do { __builtin_amdgcn_s_setprio(1); _Pragma("unroll") for (int m = 0; m < 4; ++m) _Pragma("unroll") for (int n = 0; n < 2; ++n) _Pragma("unroll") for (int k = 0; k < 2; ++k) \
      acc[ai][bj][m][n] = __builtin_amdgcn_mfma_f32_16x16x32_bf16(Bt_[n][k], At_[m][k], acc[ai][bj][m][n], 0, 0, 0); \
    __builtin_amdgcn_s_setprio(0); } while (0)
#define WAIT_V(n) asm volatile("s_waitcnt vmcnt(" #n ")" ::: "memory")
#define WAIT_L(n) asm volatile("s_waitcnt lgkmcnt(" #n ")" ::: "memory")
#define BAR __builtin_amdgcn_s_barrier()
#define SCHED __builtin_amdgcn_sched_barrier(0)
  f32x4 acc[2][2][4][2];
#pragma unroll
  for (int a = 0; a < 2; ++a)
#pragma unroll
    for (int b = 0; b < 2; ++b)
#pragma unroll
      for (int m = 0; m < 4; ++m)
#pragma unroll
        for (int n = 0; n < 2; ++n) acc[a][b][m][n] = (f32x4){0.f, 0.f, 0.f, 0.f};
  bf16x8 At[4][2], B0[2][2], B1[2][2];
  const int nt = K / BK;
  STAGEB(SB(0, 0), cB); STAGE(SA(0, 0), cA); STAGEB(SB(0, 1), cB + hstep); STAGE(SA(0, 1), cA + hstep);
  if (wr == 1) BAR;
  WAIT_V(4); BAR;
  STAGEB(SB(1, 0), cB + kstep); STAGE(SA(1, 0), cA + kstep); STAGEB(SB(1, 1), cB + hstep + kstep);
  WAIT_V(6); BAR;
  for (int t = 0; t < nt - 2; t += 2) {
    const char* a1 = cA + (size_t)(t + 1) * kstep; const char* a2 = a1 + kstep; const char* a3 = a2 + kstep;
    const char* b2 = cB + (size_t)(t + 2) * kstep; const char* b3 = b2 + kstep;
    LDB(B0, 0, 0); SCHED; LDA(At, 0, 0); STAGE(SA(1, 1), a1 + hstep);
    WAIT_L(8); BAR; WAIT_L(0); MMA(0, 0, At, B0); BAR; SCHED;
    LDB(B1, 0, 1); STAGEB(SB(0, 0), b2);
    BAR; WAIT_L(0); MMA(0, 1, At, B1); BAR;
    LDA(At, 0, 1); STAGE(SA(0, 0), a2);
    BAR; WAIT_L(0); MMA(1, 0, At, B0); BAR; SCHED;
    STAGEB(SB(0, 1), b2 + hstep);
    WAIT_V(6); BAR; MMA(1, 1, At, B1); BAR;
    LDB(B0, 1, 0); SCHED; LDA(At, 1, 0); STAGE(SA(0, 1), a2 + hstep);
    WAIT_L(8); BAR; WAIT_L(0); MMA(0, 0, At, B0); BAR; SCHED;
    LDB(B1, 1, 1); STAGEB(SB(1, 0), b3);
    BAR; WAIT_L(0); MMA(0, 1, At, B1); BAR;
    LDA(At, 1, 1); STAGE(SA(1, 0), a3);
    BAR; WAIT_L(0); MMA(1, 0, At, B0); BAR; SCHED;
    STAGEB(SB(1, 1), b3 + hstep);
    WAIT_V(6); BAR; MMA(1, 1, At, B1); BAR;
  }
  { LDB(B0, 0, 0); LDA(At, 0, 0); STAGE(SA(1, 1), cA + (size_t)(nt - 1) * kstep + hstep);
    BAR; WAIT_L(0); MMA(0, 0, At, B0); BAR;
    LDB(B1, 0, 1); BAR; WAIT_L(0); MMA(0, 1, At, B1); BAR;
    LDA(At, 0, 1); WAIT_V(4); BAR; WAIT_L(0); MMA(1, 0, At, B0); MMA(1, 1, At, B1); BAR; }
  { LDB(B0, 1, 0); LDA(At, 1, 0); WAIT_V(2); BAR; WAIT_L(0); MMA(0, 0, At, B0); BAR;
    LDB(B1, 1, 1); WAIT_V(0); BAR; WAIT_L(0); MMA(0, 1, At, B1); BAR;
    LDA(At, 1, 1); BAR; WAIT_L(0); MMA(1, 0, At, B0); MMA(1, 1, At, B1); BAR; }
  if (wr == 0) BAR;
  epi(acc, brow + wr * 64 + fr, bcol + wc * 32, fq);
  __syncthreads();
#undef SA
#undef SB
#undef STAGE
#undef STAGEB
#undef LDA
#undef LDB
#undef MMA
}

struct EpiInProj {
  bf16_t* proj; float* R; const float* b_gate; int pn;
  __device__ __forceinline__ void operator()(const f32x4 (&acc)[2][2][4][2], int row0, int colw, int fq) const {
    const int lc0 = colw - pn * 256 + fq * 8;
    if (pn < 16) {
      const bool bz = pn >= 8;
      const int cbase = (bz ? PC_BZ + (pn - 8) * 128 : PC_CX + pn * 128) + lc0;
#pragma unroll
      for (int ai = 0; ai < 2; ++ai)
#pragma unroll
        for (int m = 0; m < 4; ++m) {
          bf16_t* rp = proj + (size_t)(row0 + ai * HALF + m * 16) * LDP + cbase;
          float v[8];
#pragma unroll
          for (int n = 0; n < 2; ++n) {
            const f32x4 a = acc[ai][0][m][n], b = acc[ai][1][m][n];
            if (bz) { for (int j = 0; j < 4; ++j) v[n * 4 + j] = a[j] * silu_f(b[j]); }
            else { for (int j = 0; j < 4; ++j) v[n * 4 + j] = a[j] * b[j]; }
          }
          u32x4 w = {cvtpk(v[0], v[1]), cvtpk(v[2], v[3]), cvtpk(v[4], v[5]), cvtpk(v[6], v[7])};
          *reinterpret_cast<u32x4*>(rp) = w;
        }
      return;
    }
    if (pn == 50) {
      if (lc0 < 32) {
#pragma unroll
        for (int ai = 0; ai < 2; ++ai)
#pragma unroll
          for (int m = 0; m < 4; ++m)
#pragma unroll
            for (int n = 0; n < 2; ++n)
              *reinterpret_cast<f32x4*>(R + (size_t)(row0 + ai * HALF + m * 16) * 32 + lc0 + n * 4) = acc[ai][0][m][n];
      }
      return;
    }
    int mode, cb;
    if (pn < 20) { mode = 0; cb = PC_Q + (pn - 16) * 256; }
    else if (pn == 20) { mode = 0; cb = PC_K; }
    else if (pn == 21) { mode = 0; cb = PC_V; }
    else if (pn < 26) { mode = 1; cb = PC_ZA + (pn - 22) * 256; }
    else if (pn < 28) { mode = 0; cb = PC_GQ + (pn - 26) * 256; }
    else if (pn < 30) { mode = 0; cb = PC_GK + (pn - 28) * 256; }
    else if (pn < 34) { mode = 0; cb = PC_GV + (pn - 30) * 256; }
    else if (pn < 38) { mode = 1; cb = PC_ZG + (pn - 34) * 256; }
    else { mode = 2; cb = PC_MG + (pn - 38) * 256; }
    const int cbase = cb + lc0;
#pragma unroll
    for (int bj = 0; bj < 2; ++bj) {
      f32x4 bias0 = {0.f, 0.f, 0.f, 0.f}, bias1 = bias0;
      if (mode == 2) { const float* bp = b_gate + (pn - 38) * 256 + lc0 + bj * HALF;
        bias0 = *reinterpret_cast<const f32x4*>(bp); bias1 = *reinterpret_cast<const f32x4*>(bp + 4); }
#pragma unroll
      for (int ai = 0; ai < 2; ++ai)
#pragma unroll
        for (int m = 0; m < 4; ++m) {
          float v[8];
#pragma unroll
          for (int n = 0; n < 2; ++n) {
            const f32x4 a = acc[ai][bj][m][n]; const f32x4 bias = n ? bias1 : bias0;
            if (mode == 0) { for (int j = 0; j < 4; ++j) v[n * 4 + j] = a[j]; }
            else if (mode == 1) { for (int j = 0; j < 4; ++j) v[n * 4 + j] = silu_f(a[j]); }
            else { for (int j = 0; j < 4; ++j) v[n * 4 + j] = sigmoid_f(a[j] + bias[j]); }
          }
          u32x4 w = {cvtpk(v[0], v[1]), cvtpk(v[2], v[3]), cvtpk(v[4], v[5]), cvtpk(v[6], v[7])};
          *reinterpret_cast<u32x4*>(proj + (size_t)(row0 + ai * HALF + m * 16) * LDP + cbase + bj * HALF) = w;
        }
    }
  }
};
struct EpiMerge {
  const bf16_t* gate;
  bf16_t* M; int br;
  __device__ __forceinline__ void operator()(const f32x4 (&acc)[2][2][4][2], int row0, int colw, int fq) const {
#pragma unroll
    for (int ai = 0; ai < 2; ++ai)
#pragma unroll
      for (int m = 0; m < 4; ++m) {
        const size_t row = row0 + ai * HALF + m * 16;
#pragma unroll
        for (int bj = 0; bj < 2; ++bj) {
          const int col = colw + fq * 8 + bj * HALF;
          const u32x4 gw = *reinterpret_cast<const u32x4*>(gate + row * LDP + col);
          float v[8];
#pragma unroll
          for (int n = 0; n < 2; ++n) {
            const f32x4 a = acc[ai][bj][m][n];
            v[n * 4 + 0] = a[0] * bflo(gw[2 * n]); v[n * 4 + 1] = a[1] * bfhi(gw[2 * n]);
            v[n * 4 + 2] = a[2] * bflo(gw[2 * n + 1]); v[n * 4 + 3] = a[3] * bfhi(gw[2 * n + 1]);
          }
          bf16_t* mp = M + row * 1024 + col;
          if (br != 0) {
            const u32x4 o = *reinterpret_cast<const u32x4*>(mp);
#pragma unroll
            for (int q = 0; q < 4; ++q) { v[2 * q] += bflo(o[q]); v[2 * q + 1] += bfhi(o[q]); }
          }
          u32x4 w = {cvtpk(v[0], v[1]), cvtpk(v[2], v[3]), cvtpk(v[4], v[5]), cvtpk(v[6], v[7])};
          *reinterpret_cast<u32x4*>(mp) = w;
        }
      }
  }
};
struct EpiOutF {
  bf16_t* O;
  __device__ __forceinline__ void operator()(const f32x4 (&acc)[2][2][4][2], int row0, int colw, int fq) const {
#pragma unroll
    for (int ai = 0; ai < 2; ++ai)
#pragma unroll
      for (int m = 0; m < 4; ++m)
#pragma unroll
        for (int bj = 0; bj < 2; ++bj) {
          const f32x4 a = acc[ai][bj][m][0], b = acc[ai][bj][m][1];
          u32x4 w = {cvtpk(a[0], a[1]), cvtpk(a[2], a[3]), cvtpk(b[0], b[1]), cvtpk(b[2], b[3])};
          *reinterpret_cast<u32x4*>(O + (size_t)(row0 + ai * HALF + m * 16) * 1024 + colw + fq * 8 + bj * HALF) = w;
        }
  }
};

__device__ __forceinline__ void half_src(int ht, int& src, int& valid) {
  const int pn = ht >> 1, hf = ht & 1; valid = 128;
  if (pn < 8) src = (hf ? 2048 : 1024) + 128 * pn;
  else if (pn < 16) src = (hf ? 3072 : 0) + 128 * (pn - 8);
  else if (pn < 20) src = 4096 + (pn - 16) * 256 + hf * 128;
  else if (pn == 20) src = 5120 + hf * 128;
  else if (pn == 21) src = 5376 + hf * 128;
  else if (pn < 26) src = 5632 + (pn - 22) * 256 + hf * 128;
  else if (pn < 28) src = 6656 + (pn - 26) * 256 + hf * 128;
  else if (pn < 30) src = 7168 + (pn - 28) * 256 + hf * 128;
  else if (pn < 34) src = 7680 + (pn - 30) * 256 + hf * 128;
  else if (pn < 38) src = 8736 + (pn - 34) * 256 + hf * 128;
  else if (pn < 50) src = 9760 + (pn - 38) * 256 + hf * 128;
  else { src = 8704; valid = hf ? 0 : 32; }
}
constexpr int P0_TS = 260, P0_TILE = 64 * P0_TS;
constexpr int P0_MOD = 96, P0_WIN = 2 * 16 * 51, P0_WBR = 6 * 64, P0_WOUT = 2 * 64;
__device__ __forceinline__ void p0_lane(const Params& p, int it, int wave, int lane, int tid, const float*& lp, int& ld, bool& ok, bf16_t*& dp) {
  const float* src; bf16_t* dst; int s0, v0, s1, v1, k0;
  if (it < P0_MOD + P0_WIN) {
    const int i = it - P0_MOD, l = i / 816, r = i % 816, kb = r / 51, pn = r % 51;
    half_src(2 * pn, s0, v0); half_src(2 * pn + 1, s1, v1);
    src = p.w_in + (size_t)l * 1024 * INW; ld = INW; k0 = kb * 64; dst = (bf16_t*)(p.ws + WS_WTIN) + ((size_t)l * NPAD + pn * 256) * 1024;
  } else if (it < P0_MOD + P0_WIN + P0_WBR) {
    const int i = it - P0_MOD - P0_WIN, m = i / 64, r = i % 64, kb = r / 4, nt = r % 4, l = m / 3, br = m % 3;
    src = (br == 0 ? p.w_bc : (br == 1 ? p.w_ba : p.w_bg)) + (size_t)l * 1024 * 1024; ld = 1024;
    s0 = nt * 256; v0 = 128; s1 = nt * 256 + 128; v1 = 128; k0 = kb * 64; dst = (bf16_t*)(p.ws + WS_WTBR) + ((size_t)m * 1024 + nt * 256) * 1024;
  } else {
    const int i = it - P0_MOD - P0_WIN - P0_WBR, l = i / 64, r = i % 64, kb = r / 4, nt = r % 4;
    src = p.w_out + (size_t)l * 1024 * 1024; ld = 1024;
    s0 = nt * 256; v0 = 128; s1 = nt * 256 + 128; v1 = 128; k0 = kb * 64; dst = (bf16_t*)(p.ws + WS_WTOUT) + ((size_t)l * 1024 + nt * 256) * 1024;
  }
  const int half = lane >> 5, c4 = (lane & 31) * 4;
  lp = src + (size_t)(k0 + wave * 8) * ld + (half ? s1 : s0) + c4; ok = c4 < (half ? v1 : v0);
  dp = dst + (size_t)(tid & 255) * 1024 + k0 + (tid >> 8) * 32;
}
__device__ __forceinline__ void p0_store(const float* t, bf16_t* dp, int tid) {
  const int n = tid & 255, kh = (tid >> 8) * 32, rho = n & 31, ii = rho & 15;
  const int nsrc = (n & ~31) + 8 * (ii >> 2) + 4 * (rho >> 4) + (ii & 3);
#pragma unroll
  for (int q = 0; q < 4; ++q) {
    float v[8];
#pragma unroll
    for (int i = 0; i < 8; ++i) v[i] = t[(kh + q * 8 + i) * P0_TS + nsrc];
    u32x4 w = {cvtpk(v[0], v[1]), cvtpk(v[2], v[3]), cvtpk(v[4], v[5]), cvtpk(v[6], v[7])};
    *reinterpret_cast<u32x4*>(dp + q * 8) = w;
  }
}
__device__ __forceinline__ void phase0(const Params& p) {
  int tid_ = threadIdx.x; asm volatile("" : "+v"(tid_)); const int tid = tid_, wave = tid >> 6, lane = tid & 63;
  float* mod = (float*)(p.ws + WS_MOD);
  const int total = P0_MOD + P0_WIN + P0_WBR + P0_WOUT;
  int it = blockIdx.x;
  if (it < P0_MOD) {
    const int i = it, l = i / 48, cb = i % 48;
    float* sv = (float*)smem;
    float* red = sv + 9 * 1024;
    for (int e = tid; e < 9 * 1024; e += 512) {
      const int j = e >> 10, k = e & 1023;
      const float v = j < 8 ? p.c[j * 1024 + k] : p.c_ctx[k];
      sv[e] = silu_f(v);
    }
    __syncthreads();
    const int col = tid & 63, ks = tid >> 6;
    float a[9];
#pragma unroll
    for (int j = 0; j < 9; ++j) a[j] = 0.f;
    const float* wp = p.w_ada + (size_t)l * 1024 * 3072 + cb * 64 + col;
#pragma unroll 8
    for (int k = ks * 128; k < ks * 128 + 128; ++k) {
      const float w = wp[(size_t)k * 3072];
#pragma unroll
      for (int j = 0; j < 9; ++j) a[j] += sv[j * 1024 + k] * w;
    }
#pragma unroll
    for (int j = 0; j < 9; ++j) red[(ks * 9 + j) * 64 + col] = a[j];
    __syncthreads();
    for (int e = tid; e < 576; e += 512) {
      const int j = e >> 6, cc = e & 63;
      float s = p.b_ada[l * 3072 + cb * 64 + cc];
#pragma unroll
      for (int q = 0; q < 8; ++q) s += red[(q * 9 + j) * 64 + cc];
      mod[((size_t)l * 9 + j) * 3072 + cb * 64 + cc] = s;
    }
    __syncthreads();
    it += gridDim.x;
  }
  float* tA = (float*)smem; float* tB = tA + P0_TILE;
  const int half = lane >> 5, c4 = (lane & 31) * 4;
  for (; it < total; it += 2 * gridDim.x) {
    const int itB = it + gridDim.x; const bool hasB = itB < total;
    const float* lpA; const float* lpB = nullptr; int ldA, ldB = 0; bool okA, okB = false; bf16_t* dpA; bf16_t* dpB = nullptr;
    p0_lane(p, it, wave, lane, tid, lpA, ldA, okA, dpA);
    if (hasB) p0_lane(p, itB, wave, lane, tid, lpB, ldB, okB, dpB);
    f32x4 va[8], vb[8];
#pragma unroll
    for (int i = 0; i < 8; ++i) va[i] = okA ? *reinterpret_cast<const f32x4*>(lpA + (size_t)i * ldA) : f32x4{0.f, 0.f, 0.f, 0.f};
    if (hasB) {
#pragma unroll
      for (int i = 0; i < 8; ++i) vb[i] = okB ? *reinterpret_cast<const f32x4*>(lpB + (size_t)i * ldB) : f32x4{0.f, 0.f, 0.f, 0.f};
    }
#pragma unroll
    for (int i = 0; i < 8; ++i) *reinterpret_cast<f32x4*>(tA + (wave * 8 + i) * P0_TS + half * 128 + c4) = va[i];
    if (hasB) {
#pragma unroll
      for (int i = 0; i < 8; ++i) *reinterpret_cast<f32x4*>(tB + (wave * 8 + i) * P0_TS + half * 128 + c4) = vb[i];
    }
    __syncthreads();
    p0_store(tA, dpA, tid);
    if (hasB) p0_store(tB, dpB, tid);
    __syncthreads();
  }
}

__device__ __forceinline__ void norm_rows(const Params& p, int g, int mode, int r0, int r1, int slot, int nslot) {
  int tid_ = threadIdx.x; asm volatile("" : "+v"(tid_)); const int tid = tid_, wave = tid >> 6, lane = tid & 63;
  const float* mod = (const float*)(p.ws + WS_MOD);
  const bf16_t* outf = (const bf16_t*)(p.ws + WS_OUTF);
  bf16_t* H = (bf16_t*)(p.ws + WS_H);
  for (int row = r0 + slot * 8 + wave; row < r1; row += nslot * 8) {
    const bool lat = row < NLAT;
    const int bl = lat ? (row >> 12) : ((row - NLAT) >> 8);
    const int b = 2 * g + bl, j = lat ? b : 8;
    const size_t xoff = lat ? ((size_t)b * SEQ + (row & 4095)) * 1024 : ((size_t)b * CTXL + ((row - NLAT) & 255)) * 1024;
    f32x4 v[4];
    if (mode == 2) {
#pragma unroll
      for (int i = 0; i < 4; ++i) v[i] = *reinterpret_cast<const f32x4*>(p.out + xoff + i * 256 + lane * 4);
    } else {
      const float* xin = (lat ? p.x : p.ctx) + xoff;
#pragma unroll
      for (int i = 0; i < 4; ++i) v[i] = *reinterpret_cast<const f32x4*>(xin + i * 256 + lane * 4);
    }
    if (mode >= 1) {
      const int lp = mode - 1;
      f32x4 o[4]; float ss = 0.f;
#pragma unroll
      for (int i = 0; i < 4; ++i) { const u32x2 ow = *reinterpret_cast<const u32x2*>(outf + (size_t)row * 1024 + i * 256 + lane * 4);
        o[i] = f32x4{bflo(ow[0]), bfhi(ow[0]), bflo(ow[1]), bfhi(ow[1])};
        for (int q = 0; q < 4; ++q) ss += o[i][q] * o[i][q]; }
      ss = wave_sum(ss);
      const float rs = rsqrtf(ss * (1.f / 1024.f) + EPS);
      const float* gt = mod + ((size_t)lp * 9 + j) * 3072 + 2048;
      const float* gp = p.g_post + lp * 1024;
#pragma unroll
      for (int i = 0; i < 4; ++i) {
        const f32x4 gtv = *reinterpret_cast<const f32x4*>(gt + i * 256 + lane * 4);
        const f32x4 gpv = *reinterpret_cast<const f32x4*>(gp + i * 256 + lane * 4);
        for (int q = 0; q < 4; ++q) v[i][q] += gtv[q] * (o[i][q] * rs * gpv[q]);
      }
      if (lat) {
#pragma unroll
        for (int i = 0; i < 4; ++i) *reinterpret_cast<f32x4*>(p.out + xoff + i * 256 + lane * 4) = v[i];
      }
    }
    if (mode <= 1) {
      const int l = mode;
      float ss = 0.f;
#pragma unroll
      for (int i = 0; i < 4; ++i) for (int q = 0; q < 4; ++q) ss += v[i][q] * v[i][q];
      ss = wave_sum(ss);
      const float rs = rsqrtf(ss * (1.f / 1024.f) + EPS);
      const float* sh = mod + ((size_t)l * 9 + j) * 3072;
      const float* sc = sh + 1024;
      const float* gp = p.g_pre + l * 1024;
#pragma unroll
      for (int i = 0; i < 4; ++i) {
        const f32x4 shv = *reinterpret_cast<const f32x4*>(sh + i * 256 + lane * 4);
        const f32x4 scv = *reinterpret_cast<const f32x4*>(sc + i * 256 + lane * 4);
        const f32x4 gpv = *reinterpret_cast<const f32x4*>(gp + i * 256 + lane * 4);
        float h[4];
        for (int q = 0; q < 4; ++q) h[q] = (v[i][q] * rs * gpv[q]) * (1.f + scv[q]) + shv[q];
        u32x2 w = {cvtpk(h[0], h[1]), cvtpk(h[2], h[3])};
        *reinterpret_cast<u32x2*>(H + (size_t)row * 1024 + i * 256 + lane * 4) = w;
      }
    }
  }
}

__device__ __forceinline__ void norm_phase(const Params& p, int g, int mode) {
  norm_rows(p, g, mode, 0, (mode == 2) ? NLAT : GROWS, blockIdx.x, gridDim.x);
}

struct EpiVT {
  bf16_t* VT; int ch0;
  __device__ __forceinline__ void operator()(const f32x4 (&acc)[2][2][4][2], int row0, int colw, int fq) const {
    const int fr = row0 & 15;
#pragma unroll
    for (int ai = 0; ai < 2; ++ai)
#pragma unroll
      for (int m = 0; m < 4; ++m) {
        const int prow = row0 + ai * HALF + m * 16;
        const int ch = (prow & ~31) + 8 * (fr >> 2) + 4 * (m & 1) + (fr & 3) - ch0;
        bf16_t* rp = VT + (size_t)ch * GROWS + colw + fq * 8;
#pragma unroll
        for (int bj = 0; bj < 2; ++bj) {
          const f32x4 a = acc[ai][bj][m][0], b = acc[ai][bj][m][1];
          u32x4 w = {cvtpk(a[0], a[1]), cvtpk(a[2], a[3]), cvtpk(b[0], b[1]), cvtpk(b[2], b[3])};
          *reinterpret_cast<u32x4*>(rp + bj * HALF) = w;
        }
      }
  }
};
__device__ __forceinline__ void inproj_phase(const Params& p, int l) {
  const bf16_t* H = (const bf16_t*)(p.ws + WS_H);
  const bf16_t* W = (const bf16_t*)(p.ws + WS_WTIN) + (size_t)l * NPAD * 1024;
  EpiInProj epi; epi.proj = (bf16_t*)(p.ws + WS_PROJ); epi.R = (float*)(p.ws + WS_R); epi.b_gate = p.b_gate + l * 3072;
  EpiVT epv; epv.VT = (bf16_t*)(p.ws + WS_VT); epv.ch0 = 30 * 256;
  const int nMl = (l == 0 ? GROWS : NLAT) / 256, nN = (l == 0 ? 41 : 43), nreg = nMl * nN, nctx = (l == 0 ? 0 : 10), nvt = 4 * (GROWS / 256);
  for (int i = 0;; ++i) {
    const int L = i * gridDim.x + blockIdx.x;
    if (L < nreg) {
      int pm, pn; tile_of(L, nMl, nN, pm, pn);
      pn = pn < 30 ? pn : (pn < 40 ? pn + 4 : (pn == 40 ? 50 : pn + 3));
      epi.pn = pn;
      gemm_tile(H, W, 1024, pm * 256, pn * 256, epi);
    } else if (L < nreg + nctx) {
      const int idx = L - nreg, pm = 32 + idx / 5, c = idx % 5;
      const int pn = c == 0 ? 20 : (c == 1 ? 21 : (c == 2 ? 28 : (c == 3 ? 29 : 50)));
      epi.pn = pn;
      gemm_tile(H, W, 1024, pm * 256, pn * 256, epi);
    } else if (L < nreg + nctx + nvt) {
      const int idx0 = L - nreg - nctx, idx = (idx0 & 7) * 17 + (idx0 >> 3), ct = idx & 3, pm = idx >> 2;
      gemm_tile<EpiVT, true>(W, H, 1024, (30 + ct) * 256, pm * 256, epv);
    } else break;
  }
}

__device__ __forceinline__ void inproj_deferred_tile(const Params& p, int l, int idx0, int ndef) {
  const int x = idx0 & 7, s = idx0 >> 3, base = ndef >> 3, rem = ndef & 7;
  const int idx = x * base + (x < rem ? x : rem) + s;
  const bf16_t* H = (const bf16_t*)(p.ws + WS_H);
  const bf16_t* W = (const bf16_t*)(p.ws + WS_WTIN) + (size_t)l * NPAD * 1024;
  EpiInProj epi; epi.proj = (bf16_t*)(p.ws + WS_PROJ); epi.R = (float*)(p.ws + WS_R); epi.b_gate = p.b_gate + l * 3072;
  const int nc = (l == 0 ? 6 : 4), pm = idx / nc, pn = (l == 0 ? 44 : 46) + idx % nc;
  epi.pn = pn;
  gemm_tile(H, W, 1024, pm * 256, pn * 256, epi);
}

template <int DIR>
__device__ __forceinline__ void glaprep_item(const Params& p, int l, int chunk) {
  int tid_ = threadIdx.x; asm volatile("" : "+v"(tid_)); const int tid = tid_, c4 = tid & 127, tg = tid >> 7;
  const bf16_t* proj = (const bf16_t*)(p.ws + WS_PROJ);
  const float* R = (const float*)(p.ws + WS_R);
  bf16_t* QT = (bf16_t*)(p.ws + WS_QT) + (size_t)DIR * GROWS * 512;
  bf16_t* KT = (bf16_t*)(p.ws + WS_KT) + (size_t)DIR * GROWS * 512;
  bf16_t* KTT = (bf16_t*)(p.ws + WS_KTT) + ((size_t)DIR * 136 + chunk) * 512 * 64;
  float* E = (float*)(p.ws + WS_E) + ((size_t)DIR * 136 + chunk) * 512;
  float* Rs = (float*)smem;
  float* tot = Rs + 1024;
  const int row0 = chunk * 64;
  for (int i = tid; i < 1024; i += 512) Rs[i] = R[(size_t)(row0 + (i >> 4)) * 32 + DIR * 16 + (i & 15)];
  const float* wd = (DIR ? p.w_db : p.w_df) + (size_t)l * 16 * 512 + c4 * 4;
  f32x4 w[16];
#pragma unroll
  for (int j = 0; j < 16; ++j) w[j] = *reinterpret_cast<const f32x4*>(wd + j * 512);
  const f32x4 bb = *reinterpret_cast<const f32x4*>((DIR ? p.b_db : p.b_df) + l * 512 + c4 * 4);
  __syncthreads();
  f32x4 lc[16]; f32x4 cum = {0.f, 0.f, 0.f, 0.f};
#pragma unroll
  for (int k = 0; k < 16; ++k) {
    const int tt = DIR ? 63 - (tg * 16 + k) : tg * 16 + k;
    f32x4 z = bb;
#pragma unroll
    for (int j = 0; j < 16; ++j) { const float r = Rs[tt * 16 + j]; z += r * w[j]; }
#pragma unroll
    for (int c = 0; c < 4; ++c) cum[c] += (fminf(z[c], 0.f) - __logf(1.f + __expf(-fabsf(z[c])))) * (1.f / 16.f);
    lc[k] = cum;
  }
  *reinterpret_cast<f32x4*>(tot + tg * 512 + c4 * 4) = cum;
  __syncthreads();
  f32x4 pre = {0.f, 0.f, 0.f, 0.f}, all = {0.f, 0.f, 0.f, 0.f};
#pragma unroll
  for (int g = 0; g < 4; ++g) { const f32x4 t4 = *reinterpret_cast<const f32x4*>(tot + g * 512 + c4 * 4); all += t4; if (g < tg) pre += t4; }
  unsigned ktw[4][8];
#pragma unroll
  for (int c = 0; c < 4; ++c)
#pragma unroll
    for (int q = 0; q < 8; ++q) ktw[c][q] = 0u;
#pragma unroll
  for (int k = 0; k < 16; ++k) {
    const int tt = DIR ? 63 - (tg * 16 + k) : tg * 16 + k;
    const size_t row = row0 + tt;
    const u32x2 qw = *reinterpret_cast<const u32x2*>(proj + row * LDP + PC_GQ + c4 * 4);
    const u32x2 kw = *reinterpret_cast<const u32x2*>(proj + row * LDP + PC_GK + c4 * 4);
    const f32x4 cm = pre + lc[k];
    float qv[4] = {bflo(qw[0]), bfhi(qw[0]), bflo(qw[1]), bfhi(qw[1])};
    float kv[4] = {bflo(kw[0]), bfhi(kw[0]), bflo(kw[1]), bfhi(kw[1])};
#pragma unroll
    for (int c = 0; c < 4; ++c) { qv[c] *= 0.08838834764831845f * __expf(cm[c]); kv[c] *= __expf(-cm[c]); }
    u32x2 qo = {cvtpk(qv[0], qv[1]), cvtpk(qv[2], qv[3])}, ko = {cvtpk(kv[0], kv[1]), cvtpk(kv[2], kv[3])};
    *reinterpret_cast<u32x2*>(QT + row * 512 + c4 * 4) = qo;
    *reinterpret_cast<u32x2*>(KT + row * 512 + c4 * 4) = ko;
    constexpr int dummy = 0; (void)dummy;
    const int nk = DIR ? 15 - k : k;
    ktw[0][nk >> 1] |= (ko[0] & 0xffffu) << (16 * (nk & 1));
    ktw[1][nk >> 1] |= (ko[0] >> 16) << (16 * (nk & 1));
    ktw[2][nk >> 1] |= (ko[1] & 0xffffu) << (16 * (nk & 1));
    ktw[3][nk >> 1] |= (ko[1] >> 16) << (16 * (nk & 1));
  }
  const int base_tok = DIR ? 48 - tg * 16 : tg * 16;
#pragma unroll
  for (int c = 0; c < 4; ++c) {
    bf16_t* dst = KTT + (size_t)(c4 * 4 + c) * 64 + base_tok;
    u32x4 a = {ktw[c][0], ktw[c][1], ktw[c][2], ktw[c][3]}, b = {ktw[c][4], ktw[c][5], ktw[c][6], ktw[c][7]};
    *reinterpret_cast<u32x4*>(dst) = a; *reinterpret_cast<u32x4*>(dst + 8) = b;
  }
  if (tg == 0) {
    f32x4 ev; for (int c = 0; c < 4; ++c) ev[c] = __expf(all[c]);
    *reinterpret_cast<f32x4*>(E + c4 * 4) = ev;
  }
  __syncthreads();
}
__device__ __forceinline__ void prep_phase(const Params& p, int l) {
  for (int it = blockIdx.x; it < 272; it += gridDim.x) {
    if (it & 1) glaprep_item<1>(p, l, it >> 1); else glaprep_item<0>(p, l, it >> 1);
  }
  int tid_ = threadIdx.x; asm volatile("" : "+v"(tid_)); const int tid = tid_, wave = tid >> 6, lane = tid & 63;
  bf16_t* proj = (bf16_t*)(p.ws + WS_PROJ);
  bf16_t* kbuf = (bf16_t*)(p.ws + WS_KBUF); bf16_t* vbuf = (bf16_t*)(p.ws + WS_VBUF);
  bf16_t* UA = (bf16_t*)(p.ws + WS_UA);
  const float* qg = p.q_g + l * 128; const float* kg = p.k_g + l * 128;
  const float* cw = p.conv_w + l * 3 * 1024;
  const int axis = lane >> 5, pp = lane & 31;
  const float g1q = qg[axis * 64 + pp], g2q = qg[axis * 64 + 32 + pp];
  const float g1k = kg[axis * 64 + pp], g2k = kg[axis * 64 + 32 + pp];
  const float freq = exp2f(-(float)pp * (13.287712379549449f / 32.f));
  f32x4 cwv[2][3][2];
#pragma unroll
  for (int i = 0; i < 2; ++i)
#pragma unroll
    for (int tp = 0; tp < 3; ++tp) { const int c0 = i * 512 + lane * 8;
      cwv[i][tp][0] = *reinterpret_cast<const f32x4*>(cw + tp * 1024 + c0); cwv[i][tp][1] = *reinterpret_cast<const f32x4*>(cw + tp * 1024 + c0 + 4); }
  const int nrg = GROWS / 8, bb = blockIdx.x;
  for (int k = 0;; ++k) {
    int rg;
    if (gridDim.x == 256) { if (bb < 16) { if (k >= 2) break; rg = bb * 2 + k; } else { rg = 32 + (bb - 16) + k * 240; if (rg >= nrg) break; } }
    else { rg = bb + k * gridDim.x; if (rg >= nrg) break; }
    const int row = rg * 8 + wave;
    const bool lat = row < NLAT;
    const int bl = lat ? (row >> 12) : ((row - NLAT) >> 8);
    const int t = lat ? (row & 4095) : ((row - NLAT) & 255);
    const int slen = lat ? SEQ : CTXL;
    bf16_t* prow = proj + (size_t)row * LDP;
    float x1[10], x2[10];
#pragma unroll
    for (int hh = 0; hh < 10; ++hh) {
      const int base = PC_Q + hh * 128 + axis * 64 + pp;
      x1[hh] = bf2f(prow[base]); x2[hh] = bf2f(prow[base + 32]);
    }
    const u32x2 vw = *reinterpret_cast<const u32x2*>(prow + PC_V + lane * 4);
    u32x4 cm[2], cc[2], cp[2], bzv[2];
#pragma unroll
    for (int i = 0; i < 2; ++i) {
      const int c0 = i * 512 + lane * 8;
      const u32x4 z4 = {0u, 0u, 0u, 0u};
      cm[i] = (t > 0) ? *reinterpret_cast<const u32x4*>(prow - LDP + PC_CX + c0) : z4;
      cc[i] = *reinterpret_cast<const u32x4*>(prow + PC_CX + c0);
      cp[i] = (t < slen - 1) ? *reinterpret_cast<const u32x4*>(prow + LDP + PC_CX + c0) : z4;
      bzv[i] = *reinterpret_cast<const u32x4*>(prow + PC_BZ + c0);
    }
    float cs = 1.f, sn = 0.f;
    if (lat) {
      const float pos = (float)(axis == 0 ? (t >> 6) : (t & 63));
      float ang = pos * freq;
      const float n = rintf(ang * 0.15915494309189535f);
      ang = fmaf(n, -6.28318548202514648f, ang); ang = fmaf(n, 1.7484555e-7f, ang);
      cs = __cosf(ang); sn = __sinf(ang);
    }
    const int kpos = lat ? t : SEQ + t;
#pragma unroll
    for (int hh = 0; hh < 10; ++hh) {
      const float ss = wave_sum(x1[hh] * x1[hh] + x2[hh] * x2[hh]);
      const float rs = rsqrtf(ss * (1.f / 128.f) + EPS);
      const float y1 = x1[hh] * rs * (hh < 8 ? g1q : g1k), y2 = x2[hh] * rs * (hh < 8 ? g2q : g2k);
      const bf16_t o1 = f2bf(y1 * cs - y2 * sn), o2 = f2bf(y2 * cs + y1 * sn);
      if (hh < 8) { const int base = PC_Q + hh * 128 + axis * 64 + pp; prow[base] = o1; prow[base + 32] = o2; }
      else { bf16_t* kd = kbuf + ((size_t)(bl * 2 + (hh - 8)) * SKV + kpos) * 128 + axis * 64 + pp; kd[0] = o1; kd[32] = o2; }
    }
    {
      const int kh = lane >> 5, d = (lane & 31) * 4;
      *reinterpret_cast<u32x2*>(vbuf + ((size_t)(bl * 2 + kh) * SKV + kpos) * 128 + d) = vw;
    }
#pragma unroll
    for (int i = 0; i < 2; ++i) {
      const int c0 = i * 512 + lane * 8;
      float o[8];
#pragma unroll
      for (int q = 0; q < 4; ++q) {
        const float wl0 = cwv[i][0][q >> 1][(2 * q) & 3], wh0 = cwv[i][0][q >> 1][(2 * q + 1) & 3];
        const float wl1 = cwv[i][1][q >> 1][(2 * q) & 3], wh1 = cwv[i][1][q >> 1][(2 * q + 1) & 3];
        const float wl2 = cwv[i][2][q >> 1][(2 * q) & 3], wh2 = cwv[i][2][q >> 1][(2 * q + 1) & 3];
        o[2 * q] = bflo(bzv[i][q]) * (wl0 * bflo(cm[i][q]) + wl1 * bflo(cc[i][q]) + wl2 * bflo(cp[i][q]));
        o[2 * q + 1] = bfhi(bzv[i][q]) * (wh0 * bfhi(cm[i][q]) + wh1 * bfhi(cc[i][q]) + wh2 * bfhi(cp[i][q]));
      }
      u32x4 w = {cvtpk(o[0], o[1]), cvtpk(o[2], o[3]), cvtpk(o[4], o[5]), cvtpk(o[6], o[7])};
      *reinterpret_cast<u32x4*>(UA + (size_t)row * 1024 + c0) = w;
    }
  }
}

constexpr int AD = 128, ANW = 8, QBLK = 32, KVBLK = 64;
constexpr float ASCALE = 0.088388347648318440f;
constexpr float ATHR = 8.f;
constexpr int LDQ = LDP, LDK = 128;
constexpr size_t SHM_V = KVBLK * AD * 2, SHM_K = KVBLK * AD * 2;
#define KSWZ(row, colB) ((row) * 256 + ((colB) ^ (((row) & 7) << 4)))
#define SBAR() __builtin_amdgcn_sched_barrier(0)
__device__ __forceinline__ int crow(int r, int hi) { return (r & 3) + 8 * (r >> 2) + 4 * hi; }
__device__ __forceinline__ void partialSM(f32x16& p0, f32x16& p1, float& m_reg, float& mn, float& alpha) {
  constexpr float C = ASCALE * 1.4426950408889634f;
  float pmax = p0[0]; for (int r = 1; r < 16; ++r) pmax = fmaxf(pmax, p0[r]); for (int r = 0; r < 16; ++r) pmax = fmaxf(pmax, p1[r]);
  { auto rr = __builtin_amdgcn_permlane32_swap(__float_as_uint(pmax), __float_as_uint(pmax), false, false);
    pmax = fmaxf(__uint_as_float(rr[0]), __uint_as_float(rr[1])); }
  if (__builtin_expect(__all(pmax - m_reg <= ATHR / ASCALE), 1)) { mn = m_reg; alpha = 1.f; }
  else { mn = fmaxf(m_reg, pmax); alpha = __builtin_amdgcn_exp2f((m_reg - mn) * C); m_reg = mn; }
  float mnC = -mn * C;
  for (int r = 0; r < 16; ++r) p0[r] = fmaf(p0[r], C, mnC); for (int r = 0; r < 16; ++r) p1[r] = fmaf(p1[r], C, mnC);
  for (int r = 0; r < 16; ++r) p0[r] = __builtin_amdgcn_exp2f(p0[r]);
}
__device__ __forceinline__ void finishSM(f32x16& p0, f32x16& p1, float alpha, float& l_reg, bf16x8& pa0, bf16x8& pa1, bf16x8& pa2, bf16x8& pa3) {
  for (int r = 0; r < 16; ++r) p1[r] = __builtin_amdgcn_exp2f(p1[r]);
  float ps = 0; for (int r = 0; r < 16; ++r) ps += p0[r]; for (int r = 0; r < 16; ++r) ps += p1[r];
  { auto rr = __builtin_amdgcn_permlane32_swap(__float_as_uint(ps), __float_as_uint(ps), false, false);
    ps = __uint_as_float(rr[0]) + __uint_as_float(rr[1]); }
  l_reg = l_reg * alpha + ps;
#define PK4(P, BASE, OUT) do { unsigned a0 = cvtpk(P[BASE + 0], P[BASE + 1]), a1 = cvtpk(P[BASE + 2], P[BASE + 3]);   \
    unsigned b0 = cvtpk(P[BASE + 4], P[BASE + 5]), b1 = cvtpk(P[BASE + 6], P[BASE + 7]);                              \
    auto r0 = __builtin_amdgcn_permlane32_swap(a0, b0, false, false); auto r1 = __builtin_amdgcn_permlane32_swap(a1, b1, false, false); \
    u32x4 w = {r0[0], r1[0], r0[1], r1[1]}; OUT = *reinterpret_cast<bf16x8*>(&w); } while (0)
  PK4(p0, 0, pa0); PK4(p0, 8, pa1); PK4(p1, 0, pa2); PK4(p1, 8, pa3);
#undef PK4
}
__device__ __forceinline__ void qkt(f32x16& p0, f32x16& p1, const bf16_t* Ks, const bf16x8* qr, int r32, int hi) {
  p0 = f32x16{}; p1 = f32x16{};
  for (int d0 = 0; d0 < 8; ++d0) { int cb = (d0 * 16 + hi * 8) * 2;
    bf16x8 b0 = *reinterpret_cast<const bf16x8*>((const char*)Ks + KSWZ(r32, cb));
    bf16x8 b1 = *reinterpret_cast<const bf16x8*>((const char*)Ks + KSWZ(32 + r32, cb));
    p0 = __builtin_amdgcn_mfma_f32_32x32x16_bf16(b0, qr[d0], p0, 0, 0, 0);
    p1 = __builtin_amdgcn_mfma_f32_32x32x16_bf16(b1, qr[d0], p1, 0, 0, 0); }
}
__device__ __forceinline__ int v_st(int k, int c) { const int kk = (k & ~0xC) | ((k & 4) << 1) | ((k & 8) >> 1); return ((kk >> 3) * 4 + (c >> 5)) * 512 + ((kk & 7) * 32 + (c & 31)) * 2; }
__device__ __forceinline__ int v_rd_base(int lane) { return ((lane & 3) << 3) | (((lane >> 2) & 3) << 6) | (((lane >> 4) & 1) << 5) | (((lane >> 5) & 1) << 8); }
constexpr int v_rd_off(int d0, int ks, int half) { return d0 * 512 + ks * 4096 + half * 2048; }
template <int OFF> __device__ __forceinline__ s16x4 tr_read(int vb) {
  s16x4 r; asm volatile("ds_read_b64_tr_b16 %0, %1 offset:%2" : "=&v"(r) : "v"(vb), "i"(OFF) : "memory"); return r;
}
template <int D0> __device__ __forceinline__ void pv_one(f32x16& od, int vb, bf16x8 pa0, bf16x8 pa1, bf16x8 pa2, bf16x8 pa3) {
  const s16x4 l0 = tr_read<v_rd_off(D0, 0, 0)>(vb), h0 = tr_read<v_rd_off(D0, 0, 1)>(vb), l1 = tr_read<v_rd_off(D0, 1, 0)>(vb), h1 = tr_read<v_rd_off(D0, 1, 1)>(vb);
  const s16x4 l2 = tr_read<v_rd_off(D0, 2, 0)>(vb), h2 = tr_read<v_rd_off(D0, 2, 1)>(vb), l3 = tr_read<v_rd_off(D0, 3, 0)>(vb), h3 = tr_read<v_rd_off(D0, 3, 1)>(vb);
  asm volatile("s_waitcnt lgkmcnt(0)" ::: "memory"); SBAR();
#define PK(L, H) (bf16x8){L[0], L[1], L[2], L[3], H[0], H[1], H[2], H[3]}
  od = __builtin_amdgcn_mfma_f32_32x32x16_bf16(pa0, PK(l0, h0), od, 0, 0, 0);
  od = __builtin_amdgcn_mfma_f32_32x32x16_bf16(pa1, PK(l1, h1), od, 0, 0, 0);
  od = __builtin_amdgcn_mfma_f32_32x32x16_bf16(pa2, PK(l2, h2), od, 0, 0, 0);
  od = __builtin_amdgcn_mfma_f32_32x32x16_bf16(pa3, PK(l3, h3), od, 0, 0, 0);
#undef PK
}
__device__ __forceinline__ void pv_d0(f32x16* o, int vb, bf16x8 pa0, bf16x8 pa1, bf16x8 pa2, bf16x8 pa3) {
  pv_one<0>(o[0], vb, pa0, pa1, pa2, pa3); pv_one<1>(o[1], vb, pa0, pa1, pa2, pa3); pv_one<2>(o[2], vb, pa0, pa1, pa2, pa3); pv_one<3>(o[3], vb, pa0, pa1, pa2, pa3);
}
__device__ __forceinline__ void attn_dense_body(const bf16_t* __restrict__ Qb, const bf16_t* __restrict__ Kh, const bf16_t* __restrict__ Vh,
                                                bf16_t* __restrict__ Ob, const bf16_t* __restrict__ Zb, int seq, char* lds) {
  constexpr int SDEPTH = 2;
  int tid_ = threadIdx.x; asm volatile("" : "+v"(tid_)); const int tid = tid_, wid = tid >> 6, lane = tid & 63, r32 = lane & 31, hi = lane >> 5;
  bf16_t* V_lds = (bf16_t*)lds; bf16_t* K_lds = (bf16_t*)(lds + 2 * SHM_V);
  float* ws = (float*)(lds + 2 * SHM_V + 2 * SHM_K) + wid * 64; float* li_l = ws; float* al_l = ws + 32;
  float m_reg = -1e30f, l_reg = 0; f32x16 o[4] = {}; bf16x8 qr[8];
  const bf16_t* Qw = Qb + (long)(wid * QBLK + r32) * LDQ + hi * 8;
#pragma unroll
  for (int d0 = 0; d0 < 8; ++d0) qr[d0] = *reinterpret_cast<const bf16x8*>(Qw + d0 * 16);
  const int sr = tid >> 4, sc = (tid & 15) * 8, vst0 = v_st(sr, sc), vst1 = v_st(32 + sr, sc);
  const int vb0 = (int)(uintptr_t)V_lds + v_rd_base(lane);
  struct { bf16x8 vs0, vs1, ks0, ks1; } sr_[SDEPTH];
#define SLOAD(i, k0) do { sr_[i].vs0 = *reinterpret_cast<const bf16x8*>(&Vh[(long)((k0) + sr) * LDK + sc]); sr_[i].vs1 = *reinterpret_cast<const bf16x8*>(&Vh[(long)((k0) + 32 + sr) * LDK + sc]); \
    sr_[i].ks0 = *reinterpret_cast<const bf16x8*>(&Kh[(long)((k0) + sr) * LDK + sc]); sr_[i].ks1 = *reinterpret_cast<const bf16x8*>(&Kh[(long)((k0) + 32 + sr) * LDK + sc]); } while (0)
#define SWRITE(b, i) do { *(bf16x8*)((char*)V_lds + (b) * SHM_V + vst0) = sr_[i].vs0;          \
    *(bf16x8*)((char*)V_lds + (b) * SHM_V + vst1) = sr_[i].vs1; int kc = sc * 2;               \
    *(bf16x8*)((char*)K_lds + (b) * SHM_K + KSWZ(sr, kc)) = sr_[i].ks0;                       \
    *(bf16x8*)((char*)K_lds + (b) * SHM_K + KSWZ(32 + sr, kc)) = sr_[i].ks1; } while (0)
#define SWAIT() do { asm volatile("s_waitcnt vmcnt(4)" ::: "memory"); } while (0)
#define RESC(a) do { if (__any((a) < 1.f)) { if (hi == 0) al_l[r32] = (a); asm volatile("s_waitcnt lgkmcnt(0)" ::: "memory"); \
    for (int d = 0; d < 4; ++d) for (int r = 0; r < 16; ++r) o[d][r] *= al_l[crow(r, hi)]; } } while (0)
  f32x16 pA0, pA1, pB0, pB1; float mnA, mnB, alA, alB; bf16x8 pa0, pa1, pa2, pa3; const int NT = seq / KVBLK;
  constexpr int SE = 0, SO = SDEPTH - 1;
  SLOAD(SE, 0); asm volatile("s_waitcnt vmcnt(0)" ::: "memory"); SWRITE(0, SE); __syncthreads();
  qkt(pA0, pA1, K_lds, qr, r32, hi); partialSM(pA0, pA1, m_reg, mnA, alA);
  SLOAD(SO, KVBLK); if (2 < NT) SLOAD(SE, 2 * KVBLK);
  SWAIT(); SWRITE(1, SO); __syncthreads();
  for (int j = 1; j + 1 < NT; j += 2) {
    SBAR(); qkt(pB0, pB1, (bf16_t*)((char*)K_lds + SHM_K), qr, r32, hi);
    finishSM(pA0, pA1, alA, l_reg, pa0, pa1, pa2, pa3); SBAR();
    SLOAD(SO, (j + SDEPTH) * KVBLK); SBAR();
    pv_d0(o, vb0, pa0, pa1, pa2, pa3); partialSM(pB0, pB1, m_reg, mnB, alB);
    __syncthreads(); SWAIT(); SWRITE(0, SE);
    RESC(alB); __syncthreads();
    SBAR(); qkt(pA0, pA1, K_lds, qr, r32, hi);
    finishSM(pB0, pB1, alB, l_reg, pa0, pa1, pa2, pa3); SBAR();
    if (j + 3 < NT) SLOAD(SE, (j + 1 + SDEPTH) * KVBLK); SBAR();
    pv_d0(o, vb0 + (int)SHM_V, pa0, pa1, pa2, pa3); partialSM(pA0, pA1, m_reg, mnA, alA);
    __syncthreads(); SWAIT(); SWRITE(1, SO);
    RESC(alA); __syncthreads();
  }
  SBAR(); qkt(pB0, pB1, (bf16_t*)((char*)K_lds + SHM_K), qr, r32, hi);
  finishSM(pA0, pA1, alA, l_reg, pa0, pa1, pa2, pa3); SBAR();
  pv_d0(o, vb0, pa0, pa1, pa2, pa3); partialSM(pB0, pB1, m_reg, mnB, alB);
  __syncthreads(); RESC(alB);
  finishSM(pB0, pB1, alB, l_reg, pa0, pa1, pa2, pa3); SBAR();
  pv_d0(o, vb0 + (int)SHM_V, pa0, pa1, pa2, pa3);
  if (hi == 0) li_l[r32] = l_reg; asm volatile("s_waitcnt lgkmcnt(0)" ::: "memory");
  float rli[16];
#pragma unroll
  for (int r = 0; r < 16; ++r) rli[r] = __builtin_amdgcn_rcpf(li_l[crow(r, hi)]);
  bf16_t* Ow = Ob + (long)(wid * QBLK) * 1024;
  const bf16_t* Zw = Zb + (long)(wid * QBLK) * LDP;
#pragma unroll
  for (int r = 0; r < 16; ++r) { int orow = crow(r, hi);
    for (int d0 = 0; d0 < 4; ++d0) Ow[(long)orow * 1024 + d0 * 32 + r32] = f2bf(o[d0][r] * rli[r] * bf2f(Zw[(long)orow * LDP + d0 * 32 + r32])); }
  __syncthreads();
#undef SLOAD
#undef SWRITE
#undef SWAIT
#undef RESC
}
__device__ __forceinline__ void attn_item(const Params& p, int a) {
  const bf16_t* proj = (const bf16_t*)(p.ws + WS_PROJ);
  const bf16_t* kbuf = (const bf16_t*)(p.ws + WS_KBUF); const bf16_t* vbuf = (const bf16_t*)(p.ws + WS_VBUF);
  bf16_t* UB = (bf16_t*)(p.ws + WS_UB);
  int bl, h, row0, k0, seq;
  if (a < 256) { bl = a >> 7; h = (a >> 4) & 7; row0 = bl * SEQ + (a & 15) * 256; k0 = 0; seq = SKV; }
  else { const int i = a - 256; bl = i >> 3; h = i & 7; row0 = NLAT + bl * CTXL; k0 = SEQ; seq = CTXL; }
  const size_t kvo = ((size_t)(bl * 2 + (h >> 2)) * SKV + k0) * 128;
  attn_dense_body(proj + (size_t)row0 * LDP + PC_Q + h * 128, kbuf + kvo, vbuf + kvo, UB + (size_t)row0 * 1024 + h * 128,
                  proj + (size_t)row0 * LDP + PC_ZA + h * 128, seq, smem);
}

constexpr int GQS = 136, GTS = 72, GDV = 32;
constexpr int G_QS = 0, G_KS = 64 * GQS, G_KST = 2 * 64 * GQS, G_VST = G_KST + 128 * GTS, G_STAGE = G_VST + GDV * GTS;
constexpr int G_AS = 2 * G_STAGE, G_STS = G_AS + 64 * GTS, G_END = G_STS + GDV * GQS;
static_assert(G_END * 2 <= SMEM_MAIN, "GLA LDS");
__device__ __forceinline__ void gla_item(const Params& p, int item) {
  int tid_ = threadIdx.x; asm volatile("" : "+v"(tid_)); const int tid = tid_, w = tid >> 6, lane = tid & 63, lr = lane & 15, lq = lane >> 4;
  const int dvs = item & 7, dir = (item >> 3) & 1, head = (item >> 4) & 3, bl = item >> 6;
  const bf16_t* QT = (const bf16_t*)(p.ws + WS_QT) + (size_t)dir * GROWS * 512 + head * 128;
  const bf16_t* KT = (const bf16_t*)(p.ws + WS_KT) + (size_t)dir * GROWS * 512 + head * 128;
  const bf16_t* KTT = (const bf16_t*)(p.ws + WS_KTT) + ((size_t)dir * 136 * 512 + head * 128) * 64;
  const bf16_t* VT = (const bf16_t*)(p.ws + WS_VT) + (size_t)(head * 256 + dvs * GDV) * GROWS;
  const float* E = (const float*)(p.ws + WS_E) + (size_t)dir * 136 * 512 + head * 128 + w * 16 + lq * 4;
  bf16_t* OG = (bf16_t*)(p.ws + WS_OG) + (size_t)dir * GROWS * 1024 + head * 256 + dvs * GDV;
  bf16_t* L = (bf16_t*)smem;
  bf16_t* As = L + G_AS; bf16_t* STs = L + G_STS;
  const int srow = tid >> 3, scol = (tid & 7) * 16, vcol = (tid & 7) * 8, trow = tid >> 2, tcol = (tid & 3) * 16;
  const bool vld = tid < 256;
  f32x4 S[2];
#pragma unroll
  for (int i = 0; i < 2; ++i) S[i] = f32x4{0.f, 0.f, 0.f, 0.f};
  for (int i = tid; i < GDV * GQS / 2; i += 512) ((unsigned*)STs)[i] = 0u;
  struct Regs { u32x4 q0, q1, k0, k1, t0, t1, v0; };
  Regs RA, RB; f32x4 eA, eB;
  RA.v0 = u32x4{0u, 0u, 0u, 0u}; RB.v0 = RA.v0;
  auto chunk_row0 = [&](int c) -> int {
    if (c < 4) { const int cc = dir ? 3 - c : c; return NLAT + bl * CTXL + cc * 64; }
    const int cc = dir ? 63 - (c - 4) : (c - 4); return bl * SEQ + cc * 64;
  };
  auto gload = [&](int c, Regs& r) {
    const int r0_ = chunk_row0(c); const size_t r_ = (size_t)(r0_ + srow);
    r.q0 = *reinterpret_cast<const u32x4*>(QT + r_ * 512 + scol); r.q1 = *reinterpret_cast<const u32x4*>(QT + r_ * 512 + scol + 8);
    r.k0 = *reinterpret_cast<const u32x4*>(KT + r_ * 512 + scol); r.k1 = *reinterpret_cast<const u32x4*>(KT + r_ * 512 + scol + 8);
    const bf16_t* tp_ = KTT + ((size_t)(r0_ >> 6) * 512 + trow) * 64 + tcol;
    r.t0 = *reinterpret_cast<const u32x4*>(tp_); r.t1 = *reinterpret_cast<const u32x4*>(tp_ + 8);
    if (vld) r.v0 = *reinterpret_cast<const u32x4*>(VT + (size_t)srow * GROWS + r0_ + vcol);
  };
  auto gstore = [&](int bsel, const Regs& r) {
    bf16_t* b_ = L + bsel * G_STAGE;
    *reinterpret_cast<u32x4*>(b_ + G_QS + srow * GQS + scol) = r.q0; *reinterpret_cast<u32x4*>(b_ + G_QS + srow * GQS + scol + 8) = r.q1;
    *reinterpret_cast<u32x4*>(b_ + G_KS + srow * GQS + scol) = r.k0; *reinterpret_cast<u32x4*>(b_ + G_KS + srow * GQS + scol + 8) = r.k1;
    *reinterpret_cast<u32x4*>(b_ + G_KST + trow * GTS + tcol) = r.t0; *reinterpret_cast<u32x4*>(b_ + G_KST + trow * GTS + tcol + 8) = r.t1;
    if (vld) *reinterpret_cast<u32x4*>(b_ + G_VST + srow * GTS + vcol) = r.v0;
  };
  auto eload = [&](int c) -> f32x4 { return *reinterpret_cast<const f32x4*>(E + (size_t)(chunk_row0(c) >> 6) * 512); };
  gload(0, RA); gstore(0, RA); gload(1, RA); gload(2, RB);
  eA = eload(0); eB = eA;
  __syncthreads();
  const int tr = w >> 1, tc0 = (w & 1) * 2, tco = w & 1;
  auto step = [&](int c, Regs& RX, const f32x4& eCur, f32x4& eNext) {
    const int row0 = chunk_row0(c);
    const bf16_t* B = L + (c & 1) * G_STAGE;
    bf16x8 qf[4];
    gstore((c + 1) & 1, RX);
    gload(c + 3 < 68 ? c + 3 : 67, RX);
    eNext = eload(c + 1 < 68 ? c + 1 : 67);
    {
      f32x4 a0 = {0.f, 0.f, 0.f, 0.f}, a1 = {0.f, 0.f, 0.f, 0.f};
#pragma unroll
      for (int kk = 0; kk < 4; ++kk) {
        qf[kk] = *reinterpret_cast<const bf16x8*>(B + G_QS + (tr * 16 + lr) * GQS + kk * 32 + lq * 8);
        const bf16x8 b0 = *reinterpret_cast<const bf16x8*>(B + G_KS + (tc0 * 16 + lr) * GQS + kk * 32 + lq * 8);
        const bf16x8 b1 = *reinterpret_cast<const bf16x8*>(B + G_KS + ((tc0 + 1) * 16 + lr) * GQS + kk * 32 + lq * 8);
        a0 = __builtin_amdgcn_mfma_f32_16x16x32_bf16(b0, qf[kk], a0, 0, 0, 0);
        a1 = __builtin_amdgcn_mfma_f32_16x16x32_bf16(b1, qf[kk], a1, 0, 0, 0);
      }
      const int t = tr * 16 + lr;
#pragma unroll
      for (int j = 0; j < 4; ++j) {
        const int s0 = tc0 * 16 + lq * 4 + j, s1 = s0 + 16;
        const bool m0 = dir ? (s0 >= t) : (s0 <= t), m1 = dir ? (s1 >= t) : (s1 <= t);
        a0[j] = m0 ? a0[j] : 0.f; a1[j] = m1 ? a1[j] : 0.f;
      }
      u32x2 w0 = {cvtpk(a0[0], a0[1]), cvtpk(a0[2], a0[3])}, w1 = {cvtpk(a1[0], a1[1]), cvtpk(a1[2], a1[3])};
      *reinterpret_cast<u32x2*>(As + t * GTS + tc0 * 16 + lq * 4) = w0;
      *reinterpret_cast<u32x2*>(As + t * GTS + (tc0 + 1) * 16 + lq * 4) = w1;
    }
    __syncthreads();
    {
      f32x4 o0 = {0.f, 0.f, 0.f, 0.f};
#pragma unroll
      for (int kk = 0; kk < 2; ++kk) {
        const bf16x8 af = *reinterpret_cast<const bf16x8*>(As + (tr * 16 + lr) * GTS + kk * 32 + lq * 8);
        const bf16x8 b0 = *reinterpret_cast<const bf16x8*>(B + G_VST + (tco * 16 + lr) * GTS + kk * 32 + lq * 8);
        o0 = __builtin_amdgcn_mfma_f32_16x16x32_bf16(b0, af, o0, 0, 0, 0);
      }
#pragma unroll
      for (int kk = 0; kk < 4; ++kk) {
        const bf16x8 b0 = *reinterpret_cast<const bf16x8*>(STs + (tco * 16 + lr) * GQS + kk * 32 + lq * 8);
        o0 = __builtin_amdgcn_mfma_f32_16x16x32_bf16(b0, qf[kk], o0, 0, 0, 0);
      }
      {
        bf16_t* op = OG + (size_t)(row0 + tr * 16 + lr) * 1024 + tco * 16 + lq * 4;
        u32x2 w0 = {cvtpk(o0[0], o0[1]), cvtpk(o0[2], o0[3])};
        *reinterpret_cast<u32x2*>(op) = w0;
      }
#pragma unroll
      for (int kk = 0; kk < 2; ++kk) {
        const bf16x8 af = *reinterpret_cast<const bf16x8*>(B + G_KST + (w * 16 + lr) * GTS + kk * 32 + lq * 8);
#pragma unroll
        for (int tc = 0; tc < 2; ++tc) {
          const bf16x8 bfr = *reinterpret_cast<const bf16x8*>(B + G_VST + (tc * 16 + lr) * GTS + kk * 32 + lq * 8);
          S[tc] = __builtin_amdgcn_mfma_f32_16x16x32_bf16(af, bfr, S[tc], 0, 0, 0);
        }
      }
#pragma unroll
      for (int tc = 0; tc < 2; ++tc) S[tc] *= eCur;
    }
    __syncthreads();
#pragma unroll
    for (int tc = 0; tc < 2; ++tc) {
      u32x2 wv = {cvtpk(S[tc][0], S[tc][1]), cvtpk(S[tc][2], S[tc][3])};
      *reinterpret_cast<u32x2*>(STs + (tc * 16 + lr) * GQS + w * 16 + lq * 4) = wv;
    }
  };
#pragma unroll 1
  for (int c = 0; c < 68; c += 2) { step(c, RA, eA, eB); step(c + 1, RB, eB, eA); }
  __syncthreads();
}

__device__ __forceinline__ void glapost_rows(const Params& p, int l) {
  int tid_ = threadIdx.x; asm volatile("" : "+v"(tid_)); const int tid = tid_, wave = tid >> 6, lane = tid & 63;
  const bf16_t* OG0 = (const bf16_t*)(p.ws + WS_OG); const bf16_t* OG1 = OG0 + (size_t)GROWS * 1024;
  const bf16_t* proj = (const bf16_t*)(p.ws + WS_PROJ);
  bf16_t* UC = (bf16_t*)(p.ws + WS_UC);
  const int nrows = l == 0 ? GROWS : NLAT;
  const float* gg = p.gla_g + l * 256 + (lane & 15) * 16;
  const int ntile = (nrows / 256) * 4, nrb = (int)gridDim.x - ntile;
  for (int row = ((int)blockIdx.x - ntile) * 8 + wave; row < nrows; row += nrb * 8) {
    const size_t o = (size_t)row * 1024 + lane * 16;
    float v[16]; float ss = 0.f;
#pragma unroll
    for (int i = 0; i < 2; ++i) {
      const u32x4 a = *reinterpret_cast<const u32x4*>(OG0 + o + i * 8), b = *reinterpret_cast<const u32x4*>(OG1 + o + i * 8);
#pragma unroll
      for (int q = 0; q < 4; ++q) { v[i * 8 + 2 * q] = bflo(a[q]) + bflo(b[q]); v[i * 8 + 2 * q + 1] = bfhi(a[q]) + bfhi(b[q]); }
    }
#pragma unroll
    for (int i = 0; i < 16; ++i) ss += v[i] * v[i];
#pragma unroll
    for (int s = 8; s >= 1; s >>= 1) ss += __shfl_xor(ss, s, 64);
    const float rs = rsqrtf(ss * (1.f / 256.f) + EPS);
#pragma unroll
    for (int i = 0; i < 2; ++i) {
      const u32x4 z = *reinterpret_cast<const u32x4*>(proj + (size_t)row * LDP + PC_ZG + lane * 16 + i * 8);
      float r[8];
#pragma unroll
      for (int q = 0; q < 4; ++q) {
        r[2 * q] = v[i * 8 + 2 * q] * rs * gg[i * 8 + 2 * q] * bflo(z[q]);
        r[2 * q + 1] = v[i * 8 + 2 * q + 1] * rs * gg[i * 8 + 2 * q + 1] * bfhi(z[q]);
      }
      u32x4 wv = {cvtpk(r[0], r[1]), cvtpk(r[2], r[3]), cvtpk(r[4], r[5]), cvtpk(r[6], r[7])};
      *reinterpret_cast<u32x4*>(UC + o + i * 8) = wv;
    }
  }
}

__device__ __forceinline__ void merge_tile(const Params& p, int l, int pm, int pn, int br) {
  EpiMerge epi; epi.gate = (const bf16_t*)(p.ws + WS_PROJ) + PC_MG + br * 1024;
  epi.M = (bf16_t*)(p.ws + WS_M); epi.br = br;
  const bf16_t* Ab = (const bf16_t*)(p.ws + (br == 0 ? WS_UA : (br == 1 ? WS_UB : WS_UC)));
  const bf16_t* W = (const bf16_t*)(p.ws + WS_WTBR) + (size_t)(l * 3 + br) * 1024 * 1024;
  gemm_tile(Ab, W, 1024, pm * 256, pn * 256, epi);
}
__device__ __forceinline__ void merge_phase(const Params& p, int l) {
  const int nM = (l == 0 ? GROWS : NLAT) / 256, nN = 4;
  for (int i = 0;; ++i) {
    int pm, pn; if (!tile_of(i * gridDim.x + blockIdx.x, nM, nN, pm, pn)) break;
#pragma unroll 1
    for (int br = 2; br < 3; ++br) merge_tile(p, l, pm, pn, br);
  }
}
__device__ __forceinline__ void out_phase(const Params& p, int l) {
  const bf16_t* M = (const bf16_t*)(p.ws + WS_M);
  const bf16_t* W = (const bf16_t*)(p.ws + WS_WTOUT) + (size_t)l * 1024 * 1024;
  EpiOutF epi; epi.O = (bf16_t*)(p.ws + WS_OUTF);
  const int nM = (l == 0 ? GROWS : NLAT) / 256, nN = 4;
  for (int i = 0;; ++i) {
    int pm, pn; if (!tile_of(i * gridDim.x + blockIdx.x, nM, nN, pm, pn)) break;
    gemm_tile(M, W, 1024, pm * 256, pn * 256, epi);
  }
}


#ifndef DBG_STOP
#define DBG_STOP 0
#define DBG_WHICH 4
#endif
__device__ __forceinline__ void dbg_dump(const Params& p, int which) {
  const size_t n_out = (size_t)NB * SEQ * DM;
  const size_t gtid = (size_t)blockIdx.x * 512 + threadIdx.x, gsz = (size_t)gridDim.x * 512;
  if (which == 1) {
    const bf16_t* UB = (const bf16_t*)(p.ws + WS_UB); const bf16_t* OG = (const bf16_t*)(p.ws + WS_OG);
    const size_t n1 = (size_t)GROWS * 1024, n2 = (size_t)2 * GROWS * 1024;
    for (size_t i = gtid; i < n_out; i += gsz) {
      float v = 0.f;
      if (i < n1) v = bf2f(UB[i]);
      p.out[i] = v;
    }
  } else if (which == 4) {
    const bf16_t* QT = (const bf16_t*)(p.ws + WS_QT); const bf16_t* KT = (const bf16_t*)(p.ws + WS_KT); const float* E = (const float*)(p.ws + WS_E);
    const size_t n1 = (size_t)2 * GROWS * 512, n2 = (size_t)GROWS * 512 + 200000, n3 = (size_t)2 * 136 * 512;
    for (size_t i = gtid; i < n_out; i += gsz) {
      float v = 0.f;
      if (i < n1) v = bf2f(QT[i]); else if (i < n1 + n2) v = bf2f(KT[i - n1]); else if (i < n1 + n2 + n3) v = E[i - n1 - n2];
      p.out[i] = v;
    }
  } else if (which == 2) {
    const bf16_t* proj = (const bf16_t*)(p.ws + WS_PROJ);
    const size_t n1 = (size_t)3000 * LDP;
    for (size_t i = gtid; i < n_out; i += gsz) p.out[i] = i < n1 ? bf2f(proj[i]) : 0.f;
  } else {
    const bf16_t* outf = (const bf16_t*)(p.ws + WS_OUTF);
    const size_t n1 = (size_t)GROWS * 1024;
    for (size_t i = gtid; i < n_out; i += gsz) p.out[i] = i < n1 ? outf[i] : 0.f;
  }
}


#define XB_TMO      128
#define XB_XCNT(j)  (256  + 64 * (j))
#define XB_XSUB(j)  (1280 + 64 * (j))
#define XB_XGEN(j)  (2304 + 64 * (j))
#define XB_TOP      3328
#define XB_TOPGEN   3392
#define XCD_BAR_WORDS 3456
#define XB_SPIN_CAP (1u << 18)
__device__ __forceinline__ unsigned xb_ld(unsigned* p)              { return __hip_atomic_load(p, __ATOMIC_RELAXED, __HIP_MEMORY_SCOPE_AGENT); }
__device__ __forceinline__ unsigned xb_add(unsigned* p, unsigned v) { return __hip_atomic_fetch_add(p, v, __ATOMIC_RELAXED, __HIP_MEMORY_SCOPE_AGENT); }
__device__ __forceinline__ unsigned xb_xcc_id() { return (unsigned)__builtin_amdgcn_s_getreg((3 << 11) | 20) & 0xFu; }
#define XB_SPIN(cond, bar) do { unsigned _sp = 0; while (cond) { __builtin_amdgcn_s_sleep(1); \
    if ((++_sp & 255u) == 0u) { if (xb_ld(&(bar)[XB_TMO])) break; if (_sp > XB_SPIN_CAP) { atomicAdd(&(bar)[XB_TMO], 1u); break; } } } } while (0)
struct XcdBarrier { unsigned* bar; unsigned x; volatile LAS unsigned* st; };
__device__ __forceinline__ XcdBarrier xcd_barrier_post(unsigned* bar, volatile LAS unsigned* st) {
  XcdBarrier b; b.bar = bar; b.x = xb_xcc_id(); b.st = st;
  if (threadIdx.x == 0) (void)xb_add(&bar[XB_XCNT(b.x)], 1u);
  return b;
}
__device__ __forceinline__ void xcd_barrier_complete(unsigned* bar, unsigned x, unsigned& nloc, unsigned& nx) {
  const unsigned G = gridDim.x * gridDim.y * gridDim.z;
  unsigned sum, cnt, mine, sp = 0u;
  for (;;) {
    sum = 0u; cnt = 0u; mine = 0u;
#pragma unroll
    for (unsigned j = 0; j < 16; ++j) { const unsigned c = xb_ld(&bar[XB_XCNT(j)]); sum += c; cnt += (c > 0u) ? 1u : 0u; mine = (j == x) ? c : mine; }
    if (sum == G) break;
    __builtin_amdgcn_s_sleep(1);
    if ((++sp & 255u) == 0u) { if (xb_ld(&bar[XB_TMO])) break; if (sp > XB_SPIN_CAP) { atomicAdd(&bar[XB_TMO], 1u); break; } }
  }
  nloc = mine > 0u ? mine : 1u; nx = cnt > 0u ? cnt : 1u;
}
__device__ __forceinline__ void xcd_barrier(const XcdBarrier& b) {
  asm volatile("s_waitcnt vmcnt(0)" ::: "memory");
  __syncthreads();
  if (threadIdx.x == 0) {
    unsigned* bar = b.bar;
    __builtin_amdgcn_s_waitcnt(0);
    unsigned nloc = b.st[0], nx = b.st[1];
    if (nloc == 0u) { xcd_barrier_complete(bar, b.x, nloc, nx); b.st[0] = nloc; b.st[1] = nx; }
    const unsigned old = xb_add(&bar[XB_XSUB(b.x)], 1u);
    const unsigned gen = old / nloc;
    if (old + 1u == (gen + 1u) * nloc) {
      __builtin_amdgcn_fence(__ATOMIC_RELEASE, "agent");
      asm volatile("s_waitcnt vmcnt(0)" ::: "memory");
      const unsigned og = xb_add(&bar[XB_TOP], 1u);
      const unsigned tg = og / nx;
      if (og + 1u == (tg + 1u) * nx) xb_add(&bar[XB_TOPGEN], 1u);
      else XB_SPIN(xb_ld(&bar[XB_TOPGEN]) == tg, bar);
      __builtin_amdgcn_fence(__ATOMIC_ACQUIRE, "agent");
      xb_add(&bar[XB_XGEN(b.x)], 1u);
      asm volatile("s_waitcnt vmcnt(0)" ::: "memory");
    } else {
      XB_SPIN(xb_ld(&bar[XB_XGEN(b.x)]) == gen, bar);
      __builtin_amdgcn_fence(__ATOMIC_ACQUIRE, "agent");
      asm volatile("s_waitcnt vmcnt(0)" ::: "memory");
    }
  }
  __syncthreads();
}

__device__ __forceinline__ void glapost_phase(const Params& p, int l) {
  const int nM = (l == 0 ? GROWS : NLAT) / 256, ntile = nM * 4;
  if ((int)blockIdx.x < ntile) { int pm, pn; tile_of(blockIdx.x, nM, 4, pm, pn); merge_tile(p, l, pm, pn, 1); }
  else glapost_rows(p, l);
}
__device__ __forceinline__ void mix_phase(const Params& p, int l) {
  const int natt = (l == 0) ? 272 : 256;
  const int nM = (l == 0 ? GROWS : NLAT) / 256, nmerge = nM * 4, nctx = natt - 256, ndef = nM * (l == 0 ? 6 : 4), nextra = nmerge + nctx + ndef;
  const int b = blockIdx.x;
  for (int k = 0;; ++k) {
    int type, idx;
    if (b < 128) { if (k == 0) { type = 0; idx = ((((b & 7) << 1) | (b >> 6)) << 3) | ((b >> 3) & 7); } else if (k == 1) { type = 1; idx = 128 + ((((b & 1) << 2) | ((b >> 3) & 3)) << 4) + (((b & 7) >> 1) << 2) + (b >> 5); } else break; }
    else if (b < 256) {
      if (k == 0) { const int c = b - 128; type = 1; idx = ((((c & 1) << 2) | ((c >> 3) & 3)) << 4) + (((c & 7) >> 1) << 2) + (c >> 5); }
      else { const int e = (b - 128) + (k - 1) * 128; if (e >= nextra) break;
        if (e < nmerge) { type = 2; idx = e; } else if (e < nmerge + nctx) { type = 1; idx = 256 + e - nmerge; } else { type = 3; idx = e - nmerge - nctx; } }
    } else break;
    if (type == 0) gla_item(p, idx);
    else if (type == 1) attn_item(p, idx);
    else if (type == 2) { int pm, pn; tile_of(idx, nM, 4, pm, pn); merge_tile(p, l, pm, pn, 0); }
    else inproj_deferred_tile(p, l, idx, ndef);
  }
}

constexpr int NPHASE = 1 + 4 * 15;
__device__ __forceinline__ void run_phase(const Params& p, int ph) {
  if (ph == 0) { phase0(p); return; }
  const int q = ph - 1, g = q / 15, r = q % 15;
  if (r == 14) { norm_phase(p, g, 2); return; }
  if (r == 0 && g > 0) return;
  const int l = r / 7, s = r % 7;
  switch (s) {
    case 0: norm_phase(p, g, l); break;
    case 1: inproj_phase(p, l); break;
    case 2: prep_phase(p, l); break;
    case 3: mix_phase(p, l); break;
    case 4: glapost_phase(p, l); break;
    case 5: merge_phase(p, l); break;
    default: out_phase(p, l);
      if (l == 1 && g < 3 && (int)gridDim.x > 128) {
        if ((int)blockIdx.x >= 128) norm_rows(p, g + 1, 0, 0, GROWS, (int)blockIdx.x - 128, (int)gridDim.x - 128);
      } else if (l == 1 && g < 3) norm_phase(p, g + 1, 0);
      break;
  }
}

__global__ void __launch_bounds__(512) mega(Params p, int ph_lo, int ph_hi, int coop) {
  volatile LAS unsigned* st = (volatile LAS unsigned*)((LAS unsigned char*)smem + SMEM_MAIN);
  XcdBarrier xb; xb.bar = (unsigned*)(p.ws + WS_BAR); xb.x = 0; xb.st = st;
  if (coop) {
    if (threadIdx.x < 4) st[threadIdx.x] = 0u;
    __syncthreads();
    xb = xcd_barrier_post((unsigned*)(p.ws + WS_BAR), st);
  }
  for (int ph = ph_lo; ph < ph_hi; ++ph) {
    if (ph > 15 && (ph - 1) % 15 == 0) continue;
    run_phase(p, ph);
    if (coop && ph + 1 < ph_hi) {
      if (coop == 2) cg::this_grid().sync();
      else xcd_barrier(xb);
    }
  }
}

__global__ void __launch_bounds__(512) dbg_kernel(Params p, int which) { dbg_dump(p, which); }

#ifndef MULTI_LAUNCH
#define MULTI_LAUNCH 0
#endif

extern "C" void kernel_launch(void* const* d_in, const int* in_sizes, int n_in, void* d_out, int out_size, void* d_ws, size_t ws_size,
                              hipStream_t stream) {
  static int grid_blocks = 0;
  if (!grid_blocks) {
    if (ws_size < WS_END) { fprintf(stderr, "kernel_launch: workspace too small: %zu < %zu\n", ws_size, (size_t)WS_END); return; }
    if (hipFuncSetAttribute((const void*)mega, hipFuncAttributeMaxDynamicSharedMemorySize, SMEM_BYTES) != hipSuccess) {
      fprintf(stderr, "kernel_launch: hipFuncSetAttribute failed\n"); return; }
    int dev = 0, cus = 0, per_cu = 0;
    hipGetDevice(&dev);
    hipDeviceGetAttribute(&cus, hipDeviceAttributeMultiprocessorCount, dev);
    hipOccupancyMaxActiveBlocksPerMultiprocessor(&per_cu, mega, 512, SMEM_BYTES);
    if (per_cu < 1) per_cu = 1;
    grid_blocks = 256;
    if (cus < 256) { fprintf(stderr, "kernel_launch: needs 256 CUs, have %d\n", cus); grid_blocks = 0; return; }
  }
  Params p{};
  p.x = (const float*)d_in[0]; p.c = (const float*)d_in[1]; p.ctx = (const float*)d_in[2]; p.c_ctx = (const float*)d_in[3];
  p.w_ada = (const float*)d_in[4]; p.b_ada = (const float*)d_in[5]; p.g_pre = (const float*)d_in[6]; p.g_post = (const float*)d_in[7];
  p.w_in = (const float*)d_in[8]; p.conv_w = (const float*)d_in[9]; p.q_g = (const float*)d_in[10]; p.k_g = (const float*)d_in[11];
  p.w_df = (const float*)d_in[12]; p.b_df = (const float*)d_in[13]; p.w_db = (const float*)d_in[14]; p.b_db = (const float*)d_in[15];
  p.gla_g = (const float*)d_in[16]; p.w_bc = (const float*)d_in[17]; p.w_ba = (const float*)d_in[18]; p.w_bg = (const float*)d_in[19];
  p.b_gate = (const float*)d_in[20]; p.w_out = (const float*)d_in[21];
  p.out = (float*)d_out; p.ws = (char*)d_ws;
#if MULTI_LAUNCH
  for (int ph = 0; ph < (DBG_STOP ? DBG_STOP : NPHASE); ++ph) {
    hipLaunchKernelGGL(mega, dim3(grid_blocks), dim3(512), SMEM_BYTES, stream, p, ph, ph + 1, 0);
  }
  if (DBG_STOP) hipLaunchKernelGGL(dbg_kernel, dim3(grid_blocks), dim3(512), 0, stream, p, DBG_WHICH);
#else
  hipMemsetAsync((char*)d_ws + WS_BAR, 0, 16384, stream);
  int lo = 0, hi = NPHASE, coop = 1;
  void* args[] = {&p, &lo, &hi, &coop};
  hipError_t e = hipLaunchCooperativeKernel((void*)mega, dim3(grid_blocks), dim3(512), args, SMEM_BYTES, stream);
  if (e != hipSuccess) fprintf(stderr, "cooperative launch failed: %s (grid %d)\n", hipGetErrorString(e), grid_blocks);
#endif
}
```

```cpp
#include <hip/hip_runtime.h>
#include <hip/hip_bf16.h>
#include <hip/hip_cooperative_groups.h>
#include <cstdio>
#include <cstdint>
namespace cg = cooperative_groups;

typedef unsigned short bf16_t;
using bf16x8 = __attribute__((ext_vector_type(8))) short;
using s16x4  = __attribute__((ext_vector_type(4))) short;
using f32x4  = __attribute__((ext_vector_type(4))) float;
using f32x16 = __attribute__((ext_vector_type(16))) float;
using u32x4  = __attribute__((ext_vector_type(4))) unsigned;
using u32x2  = __attribute__((ext_vector_type(2))) unsigned;

constexpr int DM = 1024, NB = 8, SEQ = 4096, CTXL = 256, INW = 12832;
constexpr int GROWS = 8704;
constexpr int NLAT = 8192;
constexpr int NPAD = 13056;
constexpr int LDP = 10752;
constexpr int PC_CX = 0, PC_BZ = 1024, PC_Q = 2048, PC_K = 3072, PC_V = 3328, PC_ZA = 3584, PC_GQ = 4608, PC_GK = 5120,
              PC_GV = 5632, PC_ZG = 6656, PC_MG = 7680;
constexpr int SKV = 4352;
constexpr float EPS = 1e-6f;

constexpr size_t al256(size_t x) { return (x + 255) / 256 * 256; }
constexpr size_t WS_WTIN = 0;
constexpr size_t WS_WTBR = WS_WTIN + al256((size_t)2 * NPAD * 1024 * 2);
constexpr size_t WS_WTOUT = WS_WTBR + al256((size_t)2 * 3 * 1024 * 1024 * 2);
constexpr size_t WS_MOD = WS_WTOUT + al256((size_t)2 * 1024 * 1024 * 2);
constexpr size_t WS_H = WS_MOD + al256((size_t)2 * 9 * 3072 * 4);
constexpr size_t WS_PROJ = WS_H + al256((size_t)GROWS * 1024 * 2);
constexpr size_t WS_R = WS_PROJ + al256((size_t)GROWS * LDP * 2);
constexpr size_t WS_KBUF = WS_R + al256((size_t)GROWS * 32 * 4);
constexpr size_t WS_VBUF = WS_KBUF + al256((size_t)4 * SKV * 128 * 2);
constexpr size_t WS_QT = WS_VBUF + al256((size_t)4 * SKV * 128 * 2);
constexpr size_t WS_KT = WS_QT + al256((size_t)2 * GROWS * 512 * 2);
constexpr size_t WS_KTT = WS_KT + al256((size_t)2 * GROWS * 512 * 2);
constexpr size_t WS_VT = WS_KTT + al256((size_t)2 * GROWS * 512 * 2);
constexpr size_t WS_E = WS_VT + al256((size_t)1024 * GROWS * 2);
constexpr size_t WS_OG = WS_E + al256((size_t)2 * 136 * 512 * 4);
constexpr size_t WS_UA = WS_OG + al256((size_t)2 * GROWS * 1024 * 2);
constexpr size_t WS_UB = WS_UA + al256((size_t)GROWS * 1024 * 2);
constexpr size_t WS_UC = WS_UB + al256((size_t)GROWS * 1024 * 2);
constexpr size_t WS_M = WS_UC + al256((size_t)GROWS * 1024 * 2);
constexpr size_t WS_OUTF = WS_M + al256((size_t)GROWS * 1024 * 2);
constexpr size_t WS_MF = WS_OUTF;
constexpr size_t WS_BAR = WS_OUTF + al256((size_t)GROWS * 1024 * 4);
constexpr size_t WS_END = WS_BAR + 16384;
static_assert(WS_END <= (size_t)512 * 1024 * 1024, "workspace must fit 512 MiB");

struct Params {
  const float *x, *c, *ctx, *c_ctx, *w_ada, *b_ada, *g_pre, *g_post, *w_in, *conv_w, *q_g, *k_g, *w_df, *b_df, *w_db, *b_db,
      *gla_g, *w_bc, *w_ba, *w_bg, *b_gate, *w_out;
  float* out;
  char* ws;
};

extern __shared__ __attribute__((aligned(16))) char smem[];
constexpr int SMEM_MAIN = 151552;
constexpr int SMEM_BYTES = SMEM_MAIN + 256;

typedef __bf16 bf16v2_t __attribute__((ext_vector_type(2)));
typedef float f32v2_t __attribute__((ext_vector_type(2)));
__device__ __forceinline__ unsigned cvtpk(float lo, float hi) {
  f32v2_t f = {lo, hi};
  bf16v2_t b = __builtin_convertvector(f, bf16v2_t);
  return __builtin_bit_cast(unsigned, b);
}
__device__ __forceinline__ bf16_t f2bf(float x) { return (bf16_t)(cvtpk(x, 0.f) & 0xffffu); }
__device__ __forceinline__ float bf2f(bf16_t b) { return __uint_as_float(((unsigned)b) << 16); }
__device__ __forceinline__ float bflo(unsigned w) { return __uint_as_float(w << 16); }
__device__ __forceinline__ float bfhi(unsigned w) { return __uint_as_float(w & 0xffff0000u); }
__device__ __forceinline__ float wave_sum(float v) {
#pragma unroll
  for (int o = 32; o >= 1; o >>= 1) v += __shfl_xor(v, o, 64);
  return v;
}
__device__ __forceinline__ float silu_f(float x) { return x * __builtin_amdgcn_rcpf(1.f + __expf(-x)); }
__device__ __forceinline__ float sigmoid_f(float x) { return __builtin_amdgcn_rcpf(1.f + __expf(-x)); }

constexpr int BM = 256, BK = 64, HALF = 128, NXCD = 8, WGM = 8, HT = HALF * BK;
__device__ __forceinline__ int lds_byte(int r, int c) {
  int st = (r >> 4) * 2 + (c >> 5), rr = r & 15, cc = c & 31, ob = rr * 64 + cc * 2;
  return st * 1024 + (ob ^ (((ob >> 9) & 1) << 5));
}
__device__ __forceinline__ void stage_rc(int b, int& R, int& C) {
  int st = b / 1024, sb = b % 1024, swz = sb ^ (((sb >> 9) & 1) << 5);
  R = (st >> 1) * 16 + swz / 64; C = (st & 1) * 32 + (swz % 64) / 2;
}
__device__ __forceinline__ bool tile_of(int L, int nM, int nN, int& pm, int& pn) {
  const int nwg = nM * nN; if (L >= nwg) return false;
  int wgid = L; { const int q = nwg / NXCD, r = nwg % NXCD, xcd = wgid % NXCD, off = wgid / NXCD; wgid = (xcd < r ? xcd * (q + 1) : r * (q + 1) + (xcd - r) * q) + off; }
  const int nig = WGM * nN, gid = wgid / nig, fm = gid * WGM, gsz = (nM - fm) < WGM ? (nM - fm) : WGM;
  pm = fm + ((wgid % nig) % gsz); pn = (wgid % nig) / gsz; return true;
}

#define LAS __attribute__((address_space(3)))
constexpr int HTB = HALF * BK * 2;
template <class Epi, bool PERMB = false>
__device__ __forceinline__ void gemm_tile(const bf16_t* __restrict__ A, const bf16_t* __restrict__ Bt, const int K, const int brow,
                                          const int bcol, const Epi& epi) {
  LAS unsigned char* lds = (LAS unsigned char*)smem;
  int tid = threadIdx.x; asm volatile("" : "+v"(tid));
  const int wid = __builtin_amdgcn_readfirstlane(tid >> 6), lane = tid & 63, wr = wid >> 2, wc = wid & 3, fr = lane & 15, fq = lane >> 4;
  unsigned voff[2], voffb[2];
#pragma unroll
  for (int i = 0; i < 2; ++i) { int R, C; stage_rc(tid * 16 + i * 8192, R, C); voff[i] = (unsigned)(R * K + C) * 2u;
    const int rho = R & 31, ii = rho & 15, Rb = PERMB ? ((R & ~31) + 8 * (ii >> 2) + 4 * (rho >> 4) + (ii & 3)) : R;
    voffb[i] = (unsigned)(Rb * K + C) * 2u; }
  const size_t kstep = (size_t)(BK * 2), hstep = (size_t)HALF * K * 2;
  const unsigned ldsw = (unsigned)wid * 1024u;
  const int aoff = lds_byte(wr * 64 + fr, fq * 8), boff = lds_byte(wc * 32 + fr, fq * 8);
  const char* cA = (const char*)A + (size_t)brow * K * 2; const char* cB = (const char*)Bt + (size_t)bcol * K * 2;
#define SA(b, h) (((b) * 2 + (h)) * HTB)
#define SB(b, h) ((4 + (b) * 2 + (h)) * HTB)
#define STAGE(bufoff, gbase) do { _Pragma("unroll") for (int _i = 0; _i < 2; ++_i) \
    __builtin_amdgcn_global_load_lds((const unsigned*)((const char*)(gbase) + voff[_i]), (LAS unsigned*)(lds + (bufoff) + ldsw + _i * 8192), 16, 0, 0); } while (0)
#define STAGEB(bufoff, gbase) do { _Pragma("unroll") for (int _i = 0; _i < 2; ++_i) \
    __builtin_amdgcn_global_load_lds((const unsigned*)((const char*)(gbase) + voffb[_i]), (LAS unsigned*)(lds + (bufoff) + ldsw + _i * 8192), 16, 0, 0); } while (0)
#define LDA(dst, b, h) do { _Pragma("unroll") for (int m = 0; m < 4; ++m) _Pragma("unroll") for (int k = 0; k < 2; ++k) dst[m][k] = *(const LAS bf16x8*)(lds + SA(b, h) + aoff + m * 2048 + k * 1024); } while (0)
#define LDB(dst, b, h) do { _Pragma("unroll") for (int n = 0; n < 2; ++n) _Pragma("unroll") for (int k = 0; k < 2; ++k) dst[n][k] = *(const LAS bf16x8*)(lds + SB(b, h) + boff + n * 2048 + k * 1024); } while (0)
#define MMA(ai, bj, At_, Bt_) do { __builtin_amdgcn_s_setprio(1); _Pragma("unroll") for (int m = 0; m < 4; ++m) _Pragma("unroll") for (int n = 0; n < 2; ++n) _Pragma("unroll") for (int k = 0; k < 2; ++k) \
      acc[ai][bj][m][n] = __builtin_amdgcn_mfma_f32_16x16x32_bf16(Bt_[n][k], At_[m][k], acc[ai][bj][m][n], 0, 0, 0); \
    __builtin_amdgcn_s_setprio(0); } while (0)
#define WAIT_V(n) asm volatile("s_waitcnt vmcnt(" #n ")" ::: "memory")
#define WAIT_L(n) asm volatile("s_waitcnt lgkmcnt(" #n ")" ::: "memory")
#define BAR __builtin_amdgcn_s_barrier()
#define SCHED __builtin_amdgcn_sched_barrier(0)
  f32x4 acc[2][2][4][2];
#pragma unroll
  for (int a = 0; a < 2; ++a)
#pragma unroll
    for (int b = 0; b < 2; ++b)
#pragma unroll
      for (int m = 0; m < 4; ++m)
#pragma unroll
        for (int n = 0; n < 2; ++n) acc[a][b][m][n] = (f32x4){0.f, 0.f, 0.f, 0.f};
  bf16x8 At[4][2], B0[2][2], B1[2][2];
  const int nt = K / BK;
  STAGEB(SB(0, 0), cB); STAGE(SA(0, 0), cA); STAGEB(SB(0, 1), cB + hstep); STAGE(SA(0, 1), cA + hstep);
  if (wr == 1) BAR;
  WAIT_V(4); BAR;
  STAGEB(SB(1, 0), cB + kstep); STAGE(SA(1, 0), cA + kstep); STAGEB(SB(1, 1), cB + hstep + kstep);
  WAIT_V(6); BAR;
  for (int t = 0; t < nt - 2; t += 2) {
    const char* a1 = cA + (size_t)(t + 1) * kstep; const char* a2 = a1 + kstep; const char* a3 = a2 + kstep;
    const char* b2 = cB + (size_t)(t + 2) * kstep; const char* b3 = b2 + kstep;
    LDB(B0, 0, 0); SCHED; LDA(At, 0, 0); STAGE(SA(1, 1), a1 + hstep);
    WAIT_L(8); BAR; WAIT_L(0); MMA(0, 0, At, B0); BAR; SCHED;
    LDB(B1, 0, 1); STAGEB(SB(0, 0), b2);
    BAR; WAIT_L(0); MMA(0, 1, At, B1); BAR;
    LDA(At, 0, 1); STAGE(SA(0, 0), a2);
    BAR; WAIT_L(0); MMA(1, 0, At, B0); BAR; SCHED;
    STAGEB(SB(0, 1), b2 + hstep);
    WAIT_V(6); BAR; MMA(1, 1, At, B1); BAR;
    LDB(B0, 1, 0); SCHED; LDA(At, 1, 0); STAGE(SA(0, 1), a2 + hstep);
    WAIT_L(8); BAR; WAIT_L(0); MMA(0, 0, At, B0); BAR; SCHED;
    LDB(B1, 1, 1); STAGEB(SB(1, 0), b3);
    BAR; WAIT_L(0); MMA(0, 1, At, B1); BAR;
    LDA(At, 1, 1); STAGE(SA(1, 0), a3);
    BAR; WAIT_L(0); MMA(1, 0, At, B0); BAR; SCHED;
    STAGEB(SB(1, 1), b3 + hstep);
    WAIT_V(6); BAR; MMA(1, 1, At, B1); BAR;
  }
  { LDB(B0, 0, 0); LDA(At, 0, 0); STAGE(SA(1, 1), cA + (size_t)(nt - 1) * kstep + hstep);
    BAR; WAIT_L(0); MMA(0, 0, At, B0); BAR;
    LDB(B1, 0, 1); BAR; WAIT_L(0); MMA(0, 1, At, B1); BAR;
    LDA(At, 0, 1); WAIT_V(4); BAR; WAIT_L(0); MMA(1, 0, At, B0); MMA(1, 1, At, B1); BAR; }
  { LDB(B0, 1, 0); LDA(At, 1, 0); WAIT_V(2); BAR; WAIT_L(0); MMA(0, 0, At, B0); BAR;
    LDB(B1, 1, 1); WAIT_V(0); BAR; WAIT_L(0); MMA(0, 1, At, B1); BAR;
    LDA(At, 1, 1); BAR; WAIT_L(0); MMA(1, 0, At, B0); MMA(1, 1, At, B1); BAR; }
  if (wr == 0) BAR;
  epi(acc, brow + wr * 64 + fr, bcol + wc * 32, fq);
  __syncthreads();
#undef SA
#undef SB
#undef STAGE
#undef STAGEB
#undef LDA
#undef LDB
#undef MMA
}

struct TileDesc { const bf16_t* A; const bf16_t* Bt; int brow, bcol, permb; };
#define CH_SA(b, h) (((b) * 2 + (h)) * HTB)
#define CH_SB(b, h) ((4 + (b) * 2 + (h)) * HTB)
#define CH_STAGE(bufoff, gbase, VO) do { _Pragma("unroll") for (int _i = 0; _i < 2; ++_i) \
    __builtin_amdgcn_global_load_lds((const unsigned*)((const char*)(gbase) + VO[_i]), (LAS unsigned*)(lds + (bufoff) + ldsw + _i * 8192), 16, 0, 0); } while (0)
__device__ __forceinline__ void gemm_prestage(const TileDesc& d) {
  constexpr int K = 1024;
  LAS unsigned char* lds = (LAS unsigned char*)smem;
  int tid = threadIdx.x; asm volatile("" : "+v"(tid));
  const int wid = __builtin_amdgcn_readfirstlane(tid >> 6);
  unsigned voff[2], vb[2];
#pragma unroll
  for (int i = 0; i < 2; ++i) { int R, C; stage_rc(tid * 16 + i * 8192, R, C); voff[i] = (unsigned)(R * K + C) * 2u;
    const int rho = R & 31, ii = rho & 15, Rb = d.permb ? ((R & ~31) + 8 * (ii >> 2) + 4 * (rho >> 4) + (ii & 3)) : R;
    vb[i] = (unsigned)(Rb * K + C) * 2u; }
  const size_t kstep = (size_t)(BK * 2), hstep = (size_t)HALF * K * 2;
  const unsigned ldsw = (unsigned)wid * 1024u;
  const char* cA = (const char*)d.A + (size_t)d.brow * K * 2; const char* cB = (const char*)d.Bt + (size_t)d.bcol * K * 2;
  CH_STAGE(CH_SB(0, 0), cB, vb); CH_STAGE(CH_SA(0, 0), cA, voff); CH_STAGE(CH_SB(0, 1), cB + hstep, vb); CH_STAGE(CH_SA(0, 1), cA + hstep, voff);
  CH_STAGE(CH_SB(1, 0), cB + kstep, vb); CH_STAGE(CH_SA(1, 0), cA + kstep, voff); CH_STAGE(CH_SB(1, 1), cB + hstep + kstep, vb);
}
template <class Epi>
__device__ __forceinline__ void gemm_chain(const TileDesc& d, const Epi& epi, const bool has_next, const TileDesc& nx) {
  constexpr int K = 1024;
  LAS unsigned char* lds = (LAS unsigned char*)smem;
  int tid = threadIdx.x; asm volatile("" : "+v"(tid));
  const int wid = __builtin_amdgcn_readfirstlane(tid >> 6), lane = tid & 63, wr = wid >> 2, wc = wid & 3, fr = lane & 15, fq = lane >> 4;
  unsigned voff[2], vb[2];
#pragma unroll
  for (int i = 0; i < 2; ++i) { int R, C; stage_rc(tid * 16 + i * 8192, R, C); voff[i] = (unsigned)(R * K + C) * 2u;
    const int rho = R & 31, ii = rho & 15, Rb = d.permb ? ((R & ~31) + 8 * (ii >> 2) + 4 * (rho >> 4) + (ii & 3)) : R;
    vb[i] = (unsigned)(Rb * K + C) * 2u; }
  const size_t kstep = (size_t)(BK * 2), hstep = (size_t)HALF * K * 2;
  const unsigned ldsw = (unsigned)wid * 1024u;
  const int aoff = lds_byte(wr * 64 + fr, fq * 8), boff = lds_byte(wc * 32 + fr, fq * 8);
  const char* cA = (const char*)d.A + (size_t)d.brow * K * 2; const char* cB = (const char*)d.Bt + (size_t)d.bcol * K * 2;
#define SA(b, h) CH_SA(b, h)
#define SB(b, h) CH_SB(b, h)
#define STAGE(bufoff, gbase) CH_STAGE(bufoff, gbase, voff)
#define STAGEB(bufoff, gbase) CH_STAGE(bufoff, gbase, vb)
#define LDA(dst, b, h) do { _Pragma("unroll") for (int m = 0; m < 4; ++m) _Pragma("unroll") for (int k = 0; k < 2; ++k) dst[m][k] = *(const LAS bf16x8*)(lds + SA(b, h) + aoff + m * 2048 + k * 1024); } while (0)
#define LDB(dst, b, h) do { _Pragma("unroll") for (int n = 0; n < 2; ++n) _Pragma("unroll") for (int k = 0; k < 2; ++k) dst[n][k] = *(const LAS bf16x8*)(lds + SB(b, h) + boff + n * 2048 + k * 1024); } while (0)
#define MMA(ai, bj, At_, Bt_) do { __builtin_amdgcn_s_setprio(1); _Pragma("unroll") for (int m = 0; m < 4; ++m) _Pragma("unroll") for (int n = 0; n < 2; ++n) _Pragma("unroll") for (int k = 0; k < 2; ++k) \
      acc[ai][bj][m][n] = __builtin_amdgcn_mfma_f32_16x16x32_bf16(Bt_[n][k], At_[m][k], acc[ai][bj][m][n], 0, 0, 0); \
    __builtin_amdgcn_s_setprio(0); } while (0)
  f32x4 acc[2][2][4][2];
#pragma unroll
  for (int a = 0; a < 2; ++a)
#pragma unroll
    for (int b = 0; b < 2; ++b)
#pragma unroll
      for (int m = 0; m < 4; ++m)
#pragma unroll
        for (int n = 0; n < 2; ++n) acc[a][b][m][n] = (f32x4){0.f, 0.f, 0.f, 0.f};
  bf16x8 At[4][2], B0[2][2], B1[2][2];
  constexpr int nt = K / BK;
  if (wr == 1) BAR;
  WAIT_V(10); BAR;
  WAIT_V(6); BAR;
  for (int t = 0; t < nt - 2; t += 2) {
    const char* a1 = cA + (size_t)(t + 1) * kstep; const char* a2 = a1 + kstep; const char* a3 = a2 + kstep;
    const char* b2 = cB + (size_t)(t + 2) * kstep; const char* b3 = b2 + kstep;
    LDB(B0, 0, 0); SCHED; LDA(At, 0, 0); STAGE(SA(1, 1), a1 + hstep);
    WAIT_L(8); BAR; WAIT_L(0); MMA(0, 0, At, B0); BAR; SCHED;
    LDB(B1, 0, 1); STAGEB(SB(0, 0), b2);
    BAR; WAIT_L(0); MMA(0, 1, At, B1); BAR;
    LDA(At, 0, 1); STAGE(SA(0, 0), a2);
    BAR; WAIT_L(0); MMA(1, 0, At, B0); BAR; SCHED;
    STAGEB(SB(0, 1), b2 + hstep);
    WAIT_V(6); BAR; MMA(1, 1, At, B1); BAR;
    LDB(B0, 1, 0); SCHED; LDA(At, 1, 0); STAGE(SA(0, 1), a2 + hstep);
    WAIT_L(8); BAR; WAIT_L(0); MMA(0, 0, At, B0); BAR; SCHED;
    LDB(B1, 1, 1); STAGEB(SB(1, 0), b3);
    BAR; WAIT_L(0); MMA(0, 1, At, B1); BAR;
    LDA(At, 1, 1); STAGE(SA(1, 0), a3);
    BAR; WAIT_L(0); MMA(1, 0, At, B0); BAR; SCHED;
    STAGEB(SB(1, 1), b3 + hstep);
    WAIT_V(6); BAR; MMA(1, 1, At, B1); BAR;
  }
  { LDB(B0, 0, 0); LDA(At, 0, 0); STAGE(SA(1, 1), cA + (size_t)(nt - 1) * kstep + hstep);
    BAR; WAIT_L(0); MMA(0, 0, At, B0); BAR;
    LDB(B1, 0, 1); BAR; WAIT_L(0); MMA(0, 1, At, B1); BAR;
    LDA(At, 0, 1); WAIT_V(4); BAR; WAIT_L(0); MMA(1, 0, At, B0); MMA(1, 1, At, B1); BAR; }
  { LDB(B0, 1, 0); LDA(At, 1, 0); WAIT_V(2); BAR; WAIT_L(0); MMA(0, 0, At, B0); BAR;
    LDB(B1, 1, 1); WAIT_V(0); BAR; WAIT_L(0); MMA(0, 1, At, B1); BAR;
    LDA(At, 1, 1); BAR; WAIT_L(0); MMA(1, 0, At, B0); MMA(1, 1, At, B1); BAR; }
  if (wr == 0) BAR;
  SCHED;
  if (has_next) gemm_prestage(nx);
  SCHED;
  epi(acc, d.brow + wr * 64 + fr, d.bcol + wc * 32, fq);
#undef SA
#undef SB
#undef STAGE
#undef STAGEB
#undef LDA
#undef LDB
#undef MMA
}

struct EpiInProj {
  bf16_t* proj; float* R; const float* b_gate; int pn;
  __device__ __forceinline__ void operator()(const f32x4 (&acc)[2][2][4][2], int row0, int colw, int fq) const {
    const int lc0 = colw - pn * 256 + fq * 8;
    if (pn < 16) {
      const bool bz = pn >= 8;
      const int cbase = (bz ? PC_BZ + (pn - 8) * 128 : PC_CX + pn * 128) + lc0;
#pragma unroll
      for (int ai = 0; ai < 2; ++ai)
#pragma unroll
        for (int m = 0; m < 4; ++m) {
          bf16_t* rp = proj + (size_t)(row0 + ai * HALF + m * 16) * LDP + cbase;
          float v[8];
#pragma unroll
          for (int n = 0; n < 2; ++n) {
            const f32x4 a = acc[ai][0][m][n], b = acc[ai][1][m][n];
            if (bz) { for (int j = 0; j < 4; ++j) v[n * 4 + j] = a[j] * silu_f(b[j]); }
            else { for (int j = 0; j < 4; ++j) v[n * 4 + j] = a[j] * b[j]; }
          }
          u32x4 w = {cvtpk(v[0], v[1]), cvtpk(v[2], v[3]), cvtpk(v[4], v[5]), cvtpk(v[6], v[7])};
          *reinterpret_cast<u32x4*>(rp) = w;
        }
      return;
    }
    if (pn == 50) {
      if (lc0 < 32) {
#pragma unroll
        for (int ai = 0; ai < 2; ++ai)
#pragma unroll
          for (int m = 0; m < 4; ++m)
#pragma unroll
            for (int n = 0; n < 2; ++n)
              *reinterpret_cast<f32x4*>(R + (size_t)(row0 + ai * HALF + m * 16) * 32 + lc0 + n * 4) = acc[ai][0][m][n];
      }
      return;
    }
    int mode, cb;
    if (pn < 20) { mode = 0; cb = PC_Q + (pn - 16) * 256; }
    else if (pn == 20) { mode = 0; cb = PC_K; }
    else if (pn == 21) { mode = 0; cb = PC_V; }
    else if (pn < 26) { mode = 1; cb = PC_ZA + (pn - 22) * 256; }
    else if (pn < 28) { mode = 0; cb = PC_GQ + (pn - 26) * 256; }
    else if (pn < 30) { mode = 0; cb = PC_GK + (pn - 28) * 256; }
    else if (pn < 34) { mode = 0; cb = PC_GV + (pn - 30) * 256; }
    else if (pn < 38) { mode = 1; cb = PC_ZG + (pn - 34) * 256; }
    else { mode = 2; cb = PC_MG + (pn - 38) * 256; }
    const int cbase = cb + lc0;
#pragma unroll
    for (int bj = 0; bj < 2; ++bj) {
      f32x4 bias0 = {0.f, 0.f, 0.f, 0.f}, bias1 = bias0;
      if (mode == 2) { const float* bp = b_gate + (pn - 38) * 256 + lc0 + bj * HALF;
        bias0 = *reinterpret_cast<const f32x4*>(bp); bias1 = *reinterpret_cast<const f32x4*>(bp + 4); }
#pragma unroll
      for (int ai = 0; ai < 2; ++ai)
#pragma unroll
        for (int m = 0; m < 4; ++m) {
          float v[8];
#pragma unroll
          for (int n = 0; n < 2; ++n) {
            const f32x4 a = acc[ai][bj][m][n]; const f32x4 bias = n ? bias1 : bias0;
            if (mode == 0) { for (int j = 0; j < 4; ++j) v[n * 4 + j] = a[j]; }
            else if (mode == 1) { for (int j = 0; j < 4; ++j) v[n * 4 + j] = silu_f(a[j]); }
            else { for (int j = 0; j < 4; ++j) v[n * 4 + j] = sigmoid_f(a[j] + bias[j]); }
          }
          u32x4 w = {cvtpk(v[0], v[1]), cvtpk(v[2], v[3]), cvtpk(v[4], v[5]), cvtpk(v[6], v[7])};
          *reinterpret_cast<u32x4*>(proj + (size_t)(row0 + ai * HALF + m * 16) * LDP + cbase + bj * HALF) = w;
        }
    }
  }
};
struct EpiMerge {
  const bf16_t* gate;
  bf16_t* M; int br;
  __device__ __forceinline__ void operator()(const f32x4 (&acc)[2][2][4][2], int row0, int colw, int fq) const {
#pragma unroll
    for (int ai = 0; ai < 2; ++ai)
#pragma unroll
      for (int m = 0; m < 4; ++m) {
        const size_t row = row0 + ai * HALF + m * 16;
#pragma unroll
        for (int bj = 0; bj < 2; ++bj) {
          const int col = colw + fq * 8 + bj * HALF;
          const u32x4 gw = *reinterpret_cast<const u32x4*>(gate + row * LDP + col);
          float v[8];
#pragma unroll
          for (int n = 0; n < 2; ++n) {
            const f32x4 a = acc[ai][bj][m][n];
            v[n * 4 + 0] = a[0] * bflo(gw[2 * n]); v[n * 4 + 1] = a[1] * bfhi(gw[2 * n]);
            v[n * 4 + 2] = a[2] * bflo(gw[2 * n + 1]); v[n * 4 + 3] = a[3] * bfhi(gw[2 * n + 1]);
          }
          bf16_t* mp = M + row * 1024 + col;
          if (br != 0) {
            const u32x4 o = *reinterpret_cast<const u32x4*>(mp);
#pragma unroll
            for (int q = 0; q < 4; ++q) { v[2 * q] += bflo(o[q]); v[2 * q + 1] += bfhi(o[q]); }
          }
          u32x4 w = {cvtpk(v[0], v[1]), cvtpk(v[2], v[3]), cvtpk(v[4], v[5]), cvtpk(v[6], v[7])};
          *reinterpret_cast<u32x4*>(mp) = w;
        }
      }
  }
};
struct EpiOutF {
  bf16_t* O;
  __device__ __forceinline__ void operator()(const f32x4 (&acc)[2][2][4][2], int row0, int colw, int fq) const {
#pragma unroll
    for (int ai = 0; ai < 2; ++ai)
#pragma unroll
      for (int m = 0; m < 4; ++m)
#pragma unroll
        for (int bj = 0; bj < 2; ++bj) {
          const f32x4 a = acc[ai][bj][m][0], b = acc[ai][bj][m][1];
          u32x4 w = {cvtpk(a[0], a[1]), cvtpk(a[2], a[3]), cvtpk(b[0], b[1]), cvtpk(b[2], b[3])};
          *reinterpret_cast<u32x4*>(O + (size_t)(row0 + ai * HALF + m * 16) * 1024 + colw + fq * 8 + bj * HALF) = w;
        }
  }
};

__device__ __forceinline__ void half_src(int ht, int& src, int& valid) {
  const int pn = ht >> 1, hf = ht & 1; valid = 128;
  if (pn < 8) src = (hf ? 2048 : 1024) + 128 * pn;
  else if (pn < 16) src = (hf ? 3072 : 0) + 128 * (pn - 8);
  else if (pn < 20) src = 4096 + (pn - 16) * 256 + hf * 128;
  else if (pn == 20) src = 5120 + hf * 128;
  else if (pn == 21) src = 5376 + hf * 128;
  else if (pn < 26) src = 5632 + (pn - 22) * 256 + hf * 128;
  else if (pn < 28) src = 6656 + (pn - 26) * 256 + hf * 128;
  else if (pn < 30) src = 7168 + (pn - 28) * 256 + hf * 128;
  else if (pn < 34) src = 7680 + (pn - 30) * 256 + hf * 128;
  else if (pn < 38) src = 8736 + (pn - 34) * 256 + hf * 128;
  else if (pn < 50) src = 9760 + (pn - 38) * 256 + hf * 128;
  else { src = 8704; valid = hf ? 0 : 32; }
}
constexpr int P0_TS = 260, P0_TILE = 64 * P0_TS;
constexpr int P0_MOD = 96, P0_WIN = 2 * 16 * 51, P0_WBR = 6 * 64, P0_WOUT = 2 * 64;
__device__ __forceinline__ void p0_lane(const Params& p, int it, int wave, int lane, int tid, const float*& lp, int& ld, bool& ok, bf16_t*& dp) {
  const float* src; bf16_t* dst; int s0, v0, s1, v1, k0;
  if (it < P0_MOD + P0_WIN) {
    const int i = it - P0_MOD, l = i / 816, r = i % 816, kb = r / 51, pn = r % 51;
    half_src(2 * pn, s0, v0); half_src(2 * pn + 1, s1, v1);
    src = p.w_in + (size_t)l * 1024 * INW; ld = INW; k0 = kb * 64; dst = (bf16_t*)(p.ws + WS_WTIN) + ((size_t)l * NPAD + pn * 256) * 1024;
  } else if (it < P0_MOD + P0_WIN + P0_WBR) {
    const int i = it - P0_MOD - P0_WIN, m = i / 64, r = i % 64, kb = r / 4, nt = r % 4, l = m / 3, br = m % 3;
    src = (br == 0 ? p.w_bc : (br == 1 ? p.w_ba : p.w_bg)) + (size_t)l * 1024 * 1024; ld = 1024;
    s0 = nt * 256; v0 = 128; s1 = nt * 256 + 128; v1 = 128; k0 = kb * 64; dst = (bf16_t*)(p.ws + WS_WTBR) + ((size_t)m * 1024 + nt * 256) * 1024;
  } else {
    const int i = it - P0_MOD - P0_WIN - P0_WBR, l = i / 64, r = i % 64, kb = r / 4, nt = r % 4;
    src = p.w_out + (size_t)l * 1024 * 1024; ld = 1024;
    s0 = nt * 256; v0 = 128; s1 = nt * 256 + 128; v1 = 128; k0 = kb * 64; dst = (bf16_t*)(p.ws + WS_WTOUT) + ((size_t)l * 1024 + nt * 256) * 1024;
  }
  const int half = lane >> 5, c4 = (lane & 31) * 4;
  lp = src + (size_t)(k0 + wave * 8) * ld + (half ? s1 : s0) + c4; ok = c4 < (half ? v1 : v0);
  dp = dst + (size_t)(tid & 255) * 1024 + k0 + (tid >> 8) * 32;
}
__device__ __forceinline__ void p0_store(const float* t, bf16_t* dp, int tid) {
  const int n = tid & 255, kh = (tid >> 8) * 32, rho = n & 31, ii = rho & 15;
  const int nsrc = (n & ~31) + 8 * (ii >> 2) + 4 * (rho >> 4) + (ii & 3);
#pragma unroll
  for (int q = 0; q < 4; ++q) {
    float v[8];
#pragma unroll
    for (int i = 0; i < 8; ++i) v[i] = t[(kh + q * 8 + i) * P0_TS + nsrc];
    u32x4 w = {cvtpk(v[0], v[1]), cvtpk(v[2], v[3]), cvtpk(v[4], v[5]), cvtpk(v[6], v[7])};
    *reinterpret_cast<u32x4*>(dp + q * 8) = w;
  }
}
__device__ __forceinline__ void phase0(const Params& p) {
  int tid_ = threadIdx.x; asm volatile("" : "+v"(tid_)); const int tid = tid_, wave = tid >> 6, lane = tid & 63;
  float* mod = (float*)(p.ws + WS_MOD);
  const int total = P0_MOD + P0_WIN + P0_WBR + P0_WOUT;
  int it = blockIdx.x;
  if (it < P0_MOD) {
    const int i = it, l = i / 48, cb = i % 48;
    float* sv = (float*)smem;
    float* red = sv + 9 * 1024;
    for (int e = tid; e < 9 * 1024; e += 512) {
      const int j = e >> 10, k = e & 1023;
      const float v = j < 8 ? p.c[j * 1024 + k] : p.c_ctx[k];
      sv[e] = silu_f(v);
    }
    __syncthreads();
    const int col = tid & 63, ks = tid >> 6;
    float a[9];
#pragma unroll
    for (int j = 0; j < 9; ++j) a[j] = 0.f;
    const float* wp = p.w_ada + (size_t)l * 1024 * 3072 + cb * 64 + col;
#pragma unroll 8
    for (int k = ks * 128; k < ks * 128 + 128; ++k) {
      const float w = wp[(size_t)k * 3072];
#pragma unroll
      for (int j = 0; j < 9; ++j) a[j] += sv[j * 1024 + k] * w;
    }
#pragma unroll
    for (int j = 0; j < 9; ++j) red[(ks * 9 + j) * 64 + col] = a[j];
    __syncthreads();
    for (int e = tid; e < 576; e += 512) {
      const int j = e >> 6, cc = e & 63;
      float s = p.b_ada[l * 3072 + cb * 64 + cc];
#pragma unroll
      for (int q = 0; q < 8; ++q) s += red[(q * 9 + j) * 64 + cc];
      mod[((size_t)l * 9 + j) * 3072 + cb * 64 + cc] = s;
    }
    __syncthreads();
    it += gridDim.x;
  }
  float* tA = (float*)smem; float* tB = tA + P0_TILE;
  const int half = lane >> 5, c4 = (lane & 31) * 4;
  for (; it < total; it += 2 * gridDim.x) {
    const int itB = it + gridDim.x; const bool hasB = itB < total;
    const float* lpA; const float* lpB = nullptr; int ldA, ldB = 0; bool okA, okB = false; bf16_t* dpA; bf16_t* dpB = nullptr;
    p0_lane(p, it, wave, lane, tid, lpA, ldA, okA, dpA);
    if (hasB) p0_lane(p, itB, wave, lane, tid, lpB, ldB, okB, dpB);
    f32x4 va[8], vb[8];
#pragma unroll
    for (int i = 0; i < 8; ++i) va[i] = okA ? *reinterpret_cast<const f32x4*>(lpA + (size_t)i * ldA) : f32x4{0.f, 0.f, 0.f, 0.f};
    if (hasB) {
#pragma unroll
      for (int i = 0; i < 8; ++i) vb[i] = okB ? *reinterpret_cast<const f32x4*>(lpB + (size_t)i * ldB) : f32x4{0.f, 0.f, 0.f, 0.f};
    }
#pragma unroll
    for (int i = 0; i < 8; ++i) *reinterpret_cast<f32x4*>(tA + (wave * 8 + i) * P0_TS + half * 128 + c4) = va[i];
    if (hasB) {
#pragma unroll
      for (int i = 0; i < 8; ++i) *reinterpret_cast<f32x4*>(tB + (wave * 8 + i) * P0_TS + half * 128 + c4) = vb[i];
    }
    __syncthreads();
    p0_store(tA, dpA, tid);
    if (hasB) p0_store(tB, dpB, tid);
    __syncthreads();
  }
}

__device__ __forceinline__ void norm_rows(const Params& p, int g, int mode, int r0, int r1, int slot, int nslot) {
  int tid_ = threadIdx.x; asm volatile("" : "+v"(tid_)); const int tid = tid_, wave = tid >> 6, lane = tid & 63;
  const float* mod = (const float*)(p.ws + WS_MOD);
  const bf16_t* outf = (const bf16_t*)(p.ws + WS_OUTF);
  bf16_t* H = (bf16_t*)(p.ws + WS_H);
  for (int row = r0 + slot * 8 + wave; row < r1; row += nslot * 8) {
    const bool lat = row < NLAT;
    const int bl = lat ? (row >> 12) : ((row - NLAT) >> 8);
    const int b = 2 * g + bl, j = lat ? b : 8;
    const size_t xoff = lat ? ((size_t)b * SEQ + (row & 4095)) * 1024 : ((size_t)b * CTXL + ((row - NLAT) & 255)) * 1024;
    f32x4 v[4];
    if (mode == 2) {
#pragma unroll
      for (int i = 0; i < 4; ++i) v[i] = *reinterpret_cast<const f32x4*>(p.out + xoff + i * 256 + lane * 4);
    } else {
      const float* xin = (lat ? p.x : p.ctx) + xoff;
#pragma unroll
      for (int i = 0; i < 4; ++i) v[i] = *reinterpret_cast<const f32x4*>(xin + i * 256 + lane * 4);
    }
    if (mode >= 1) {
      const int lp = mode - 1;
      f32x4 o[4]; float ss = 0.f;
#pragma unroll
      for (int i = 0; i < 4; ++i) { const u32x2 ow = *reinterpret_cast<const u32x2*>(outf + (size_t)row * 1024 + i * 256 + lane * 4);
        o[i] = f32x4{bflo(ow[0]), bfhi(ow[0]), bflo(ow[1]), bfhi(ow[1])};
        for (int q = 0; q < 4; ++q) ss += o[i][q] * o[i][q]; }
      ss = wave_sum(ss);
      const float rs = rsqrtf(ss * (1.f / 1024.f) + EPS);
      const float* gt = mod + ((size_t)lp * 9 + j) * 3072 + 2048;
      const float* gp = p.g_post + lp * 1024;
#pragma unroll
      for (int i = 0; i < 4; ++i) {
        const f32x4 gtv = *reinterpret_cast<const f32x4*>(gt + i * 256 + lane * 4);
        const f32x4 gpv = *reinterpret_cast<const f32x4*>(gp + i * 256 + lane * 4);
        for (int q = 0; q < 4; ++q) v[i][q] += gtv[q] * (o[i][q] * rs * gpv[q]);
      }
      if (lat) {
#pragma unroll
        for (int i = 0; i < 4; ++i) *reinterpret_cast<f32x4*>(p.out + xoff + i * 256 + lane * 4) = v[i];
      }
    }
    if (mode <= 1) {
      const int l = mode;
      float ss = 0.f;
#pragma unroll
      for (int i = 0; i < 4; ++i) for (int q = 0; q < 4; ++q) ss += v[i][q] * v[i][q];
      ss = wave_sum(ss);
      const float rs = rsqrtf(ss * (1.f / 1024.f) + EPS);
      const float* sh = mod + ((size_t)l * 9 + j) * 3072;
      const float* sc = sh + 1024;
      const float* gp = p.g_pre + l * 1024;
#pragma unroll
      for (int i = 0; i < 4; ++i) {
        const f32x4 shv = *reinterpret_cast<const f32x4*>(sh + i * 256 + lane * 4);
        const f32x4 scv = *reinterpret_cast<const f32x4*>(sc + i * 256 + lane * 4);
        const f32x4 gpv = *reinterpret_cast<const f32x4*>(gp + i * 256 + lane * 4);
        float h[4];
        for (int q = 0; q < 4; ++q) h[q] = (v[i][q] * rs * gpv[q]) * (1.f + scv[q]) + shv[q];
        u32x2 w = {cvtpk(h[0], h[1]), cvtpk(h[2], h[3])};
        *reinterpret_cast<u32x2*>(H + (size_t)row * 1024 + i * 256 + lane * 4) = w;
      }
    }
  }
}

__device__ __forceinline__ void norm_phase(const Params& p, int g, int mode) {
  norm_rows(p, g, mode, 0, (mode == 2) ? NLAT : GROWS, blockIdx.x, gridDim.x);
}

struct EpiVT {
  bf16_t* VT; int ch0;
  __device__ __forceinline__ void operator()(const f32x4 (&acc)[2][2][4][2], int row0, int colw, int fq) const {
    const int fr = row0 & 15;
#pragma unroll
    for (int ai = 0; ai < 2; ++ai)
#pragma unroll
      for (int m = 0; m < 4; ++m) {
        const int prow = row0 + ai * HALF + m * 16;
        const int ch = (prow & ~31) + 8 * (fr >> 2) + 4 * (m & 1) + (fr & 3) - ch0;
        bf16_t* rp = VT + (size_t)ch * GROWS + colw + fq * 8;
#pragma unroll
        for (int bj = 0; bj < 2; ++bj) {
          const f32x4 a = acc[ai][bj][m][0], b = acc[ai][bj][m][1];
          u32x4 w = {cvtpk(a[0], a[1]), cvtpk(a[2], a[3]), cvtpk(b[0], b[1]), cvtpk(b[2], b[3])};
          *reinterpret_cast<u32x4*>(rp + bj * HALF) = w;
        }
      }
  }
};
__device__ __forceinline__ bool inproj_desc(const bf16_t* H, const bf16_t* W, int l, int L, TileDesc& d, int& pn_out) {
  const int nMl = (l == 0 ? GROWS : NLAT) / 256, nN = (l == 0 ? 41 : 43), nreg = nMl * nN, nctx = (l == 0 ? 0 : 10), nvt = 4 * (GROWS / 256);
  if (L < nreg) {
    int pm, pn; tile_of(L, nMl, nN, pm, pn);
    pn = pn < 30 ? pn : (pn < 40 ? pn + 4 : (pn == 40 ? 50 : pn + 3));
    d.A = H; d.Bt = W; d.brow = pm * 256; d.bcol = pn * 256; d.permb = 0; pn_out = pn; return true;
  }
  if (L < nreg + nctx) {
    const int idx = L - nreg, pm = 32 + idx / 5, c = idx % 5;
    const int pn = c == 0 ? 20 : (c == 1 ? 21 : (c == 2 ? 28 : (c == 3 ? 29 : 50)));
    d.A = H; d.Bt = W; d.brow = pm * 256; d.bcol = pn * 256; d.permb = 0; pn_out = pn; return true;
  }
  if (L < nreg + nctx + nvt) {
    const int idx0 = L - nreg - nctx, idx = (idx0 & 7) * 17 + (idx0 >> 3), ct = idx & 3, pm = idx >> 2;
    d.A = W; d.Bt = H; d.brow = (30 + ct) * 256; d.bcol = pm * 256; d.permb = 1; pn_out = -1; return true;
  }
  return false;
}
__device__ __forceinline__ void inproj_phase(const Params& p, int l) {
  const bf16_t* H = (const bf16_t*)(p.ws + WS_H);
  const bf16_t* W = (const bf16_t*)(p.ws + WS_WTIN) + (size_t)l * NPAD * 1024;
  EpiInProj epi; epi.proj = (bf16_t*)(p.ws + WS_PROJ); epi.R = (float*)(p.ws + WS_R); epi.b_gate = p.b_gate + l * 3072;
  EpiVT epv; epv.VT = (bf16_t*)(p.ws + WS_VT); epv.ch0 = 30 * 256;
  TileDesc cur, nxt; int pn, pnn;
  bool have = inproj_desc(H, W, l, blockIdx.x, cur, pn);
  if (have) gemm_prestage(cur);
  for (int i = 1; have; ++i) {
    const bool hn = inproj_desc(H, W, l, i * gridDim.x + blockIdx.x, nxt, pnn);
    if (pn >= 0) { epi.pn = pn; gemm_chain(cur, epi, hn, nxt); }
    else gemm_chain(cur, epv, hn, nxt);
    cur = nxt; pn = pnn; have = hn;
  }
  __syncthreads();
}

__device__ __forceinline__ void inproj_deferred_tile(const Params& p, int l, int idx0, int ndef) {
  const int x = idx0 & 7, s = idx0 >> 3, base = ndef >> 3, rem = ndef & 7;
  const int idx = x * base + (x < rem ? x : rem) + s;
  const bf16_t* H = (const bf16_t*)(p.ws + WS_H);
  const bf16_t* W = (const bf16_t*)(p.ws + WS_WTIN) + (size_t)l * NPAD * 1024;
  EpiInProj epi; epi.proj = (bf16_t*)(p.ws + WS_PROJ); epi.R = (float*)(p.ws + WS_R); epi.b_gate = p.b_gate + l * 3072;
  const int nc = (l == 0 ? 6 : 4), pm = idx / nc, pn = (l == 0 ? 44 : 46) + idx % nc;
  epi.pn = pn;
  gemm_tile(H, W, 1024, pm * 256, pn * 256, epi);
}

template <int DIR>
__device__ __forceinline__ void glaprep_item(const Params& p, int l, int chunk) {
  int tid_ = threadIdx.x; asm volatile("" : "+v"(tid_)); const int tid = tid_, c4 = tid & 127, tg = tid >> 7;
  const bf16_t* proj = (const bf16_t*)(p.ws + WS_PROJ);
  const float* R = (const float*)(p.ws + WS_R);
  bf16_t* QT = (bf16_t*)(p.ws + WS_QT) + (size_t)DIR * GROWS * 512;
  bf16_t* KT = (bf16_t*)(p.ws + WS_KT) + (size_t)DIR * GROWS * 512;
  bf16_t* KTT = (bf16_t*)(p.ws + WS_KTT) + ((size_t)DIR * 136 + chunk) * 512 * 64;
  float* E = (float*)(p.ws + WS_E) + ((size_t)DIR * 136 + chunk) * 512;
  float* Rs = (float*)smem;
  float* tot = Rs + 1024;
  const int row0 = chunk * 64;
  for (int i = tid; i < 1024; i += 512) Rs[i] = R[(size_t)(row0 + (i >> 4)) * 32 + DIR * 16 + (i & 15)];
  const float* wd = (DIR ? p.w_db : p.w_df) + (size_t)l * 16 * 512 + c4 * 4;
  f32x4 w[16];
#pragma unroll
  for (int j = 0; j < 16; ++j) w[j] = *reinterpret_cast<const f32x4*>(wd + j * 512);
  const f32x4 bb = *reinterpret_cast<const f32x4*>((DIR ? p.b_db : p.b_df) + l * 512 + c4 * 4);
  __syncthreads();
  f32x4 lc[16]; f32x4 cum = {0.f, 0.f, 0.f, 0.f};
#pragma unroll
  for (int k = 0; k < 16; ++k) {
    const int tt = DIR ? 63 - (tg * 16 + k) : tg * 16 + k;
    f32x4 z = bb;
#pragma unroll
    for (int j = 0; j < 16; ++j) { const float r = Rs[tt * 16 + j]; z += r * w[j]; }
#pragma unroll
    for (int c = 0; c < 4; ++c) cum[c] += (fminf(z[c], 0.f) - __logf(1.f + __expf(-fabsf(z[c])))) * (1.f / 16.f);
    lc[k] = cum;
  }
  *reinterpret_cast<f32x4*>(tot + tg * 512 + c4 * 4) = cum;
  __syncthreads();
  f32x4 pre = {0.f, 0.f, 0.f, 0.f}, all = {0.f, 0.f, 0.f, 0.f};
#pragma unroll
  for (int g = 0; g < 4; ++g) { const f32x4 t4 = *reinterpret_cast<const f32x4*>(tot + g * 512 + c4 * 4); all += t4; if (g < tg) pre += t4; }
  unsigned ktw[4][8];
#pragma unroll
  for (int c = 0; c < 4; ++c)
#pragma unroll
    for (int q = 0; q < 8; ++q) ktw[c][q] = 0u;
#pragma unroll
  for (int k = 0; k < 16; ++k) {
    const int tt = DIR ? 63 - (tg * 16 + k) : tg * 16 + k;
    const size_t row = row0 + tt;
    const u32x2 qw = *reinterpret_cast<const u32x2*>(proj + row * LDP + PC_GQ + c4 * 4);
    const u32x2 kw = *reinterpret_cast<const u32x2*>(proj + row * LDP + PC_GK + c4 * 4);
    const f32x4 cm = pre + lc[k];
    float qv[4] = {bflo(qw[0]), bfhi(qw[0]), bflo(qw[1]), bfhi(qw[1])};
    float kv[4] = {bflo(kw[0]), bfhi(kw[0]), bflo(kw[1]), bfhi(kw[1])};
#pragma unroll
    for (int c = 0; c < 4; ++c) { qv[c] *= 0.08838834764831845f * __expf(cm[c]); kv[c] *= __expf(-cm[c]); }
    u32x2 qo = {cvtpk(qv[0], qv[1]), cvtpk(qv[2], qv[3])}, ko = {cvtpk(kv[0], kv[1]), cvtpk(kv[2], kv[3])};
    *reinterpret_cast<u32x2*>(QT + row * 512 + c4 * 4) = qo;
    *reinterpret_cast<u32x2*>(KT + row * 512 + c4 * 4) = ko;
    constexpr int dummy = 0; (void)dummy;
    const int nk = DIR ? 15 - k : k;
    ktw[0][nk >> 1] |= (ko[0] & 0xffffu) << (16 * (nk & 1));
    ktw[1][nk >> 1] |= (ko[0] >> 16) << (16 * (nk & 1));
    ktw[2][nk >> 1] |= (ko[1] & 0xffffu) << (16 * (nk & 1));
    ktw[3][nk >> 1] |= (ko[1] >> 16) << (16 * (nk & 1));
  }
  const int base_tok = DIR ? 48 - tg * 16 : tg * 16;
#pragma unroll
  for (int c = 0; c < 4; ++c) {
    bf16_t* dst = KTT + (size_t)(c4 * 4 + c) * 64 + base_tok;
    u32x4 a = {ktw[c][0], ktw[c][1], ktw[c][2], ktw[c][3]}, b = {ktw[c][4], ktw[c][5], ktw[c][6], ktw[c][7]};
    *reinterpret_cast<u32x4*>(dst) = a; *reinterpret_cast<u32x4*>(dst + 8) = b;
  }
  if (tg == 0) {
    f32x4 ev; for (int c = 0; c < 4; ++c) ev[c] = __expf(all[c]);
    *reinterpret_cast<f32x4*>(E + c4 * 4) = ev;
  }
  __syncthreads();
}
__device__ __forceinline__ void prep_phase(const Params& p, int l) {
  for (int it = blockIdx.x; it < 272; it += gridDim.x) {
    if (it & 1) glaprep_item<1>(p, l, it >> 1); else glaprep_item<0>(p, l, it >> 1);
  }
  int tid_ = threadIdx.x; asm volatile("" : "+v"(tid_)); const int tid = tid_, wave = tid >> 6, lane = tid & 63;
  bf16_t* proj = (bf16_t*)(p.ws + WS_PROJ);
  bf16_t* kbuf = (bf16_t*)(p.ws + WS_KBUF); bf16_t* vbuf = (bf16_t*)(p.ws + WS_VBUF);
  bf16_t* UA = (bf16_t*)(p.ws + WS_UA);
  const float* qg = p.q_g + l * 128; const float* kg = p.k_g + l * 128;
  const float* cw = p.conv_w + l * 3 * 1024;
  const int axis = lane >> 5, pp = lane & 31;
  const float g1q = qg[axis * 64 + pp], g2q = qg[axis * 64 + 32 + pp];
  const float g1k = kg[axis * 64 + pp], g2k = kg[axis * 64 + 32 + pp];
  const float freq = exp2f(-(float)pp * (13.287712379549449f / 32.f));
  f32x4 cwv[2][3][2];
#pragma unroll
  for (int i = 0; i < 2; ++i)
#pragma unroll
    for (int tp = 0; tp < 3; ++tp) { const int c0 = i * 512 + lane * 8;
      cwv[i][tp][0] = *reinterpret_cast<const f32x4*>(cw + tp * 1024 + c0); cwv[i][tp][1] = *reinterpret_cast<const f32x4*>(cw + tp * 1024 + c0 + 4); }
  const int nrg = GROWS / 8, bb = blockIdx.x;
  for (int k = 0;; ++k) {
    int rg;
    if (gridDim.x == 256) { if (bb < 16) { if (k >= 2) break; rg = bb * 2 + k; } else { rg = 32 + (bb - 16) + k * 240; if (rg >= nrg) break; } }
    else { rg = bb + k * gridDim.x; if (rg >= nrg) break; }
    const int row = rg * 8 + wave;
    const bool lat = row < NLAT;
    const int bl = lat ? (row >> 12) : ((row - NLAT) >> 8);
    const int t = lat ? (row & 4095) : ((row - NLAT) & 255);
    const int slen = lat ? SEQ : CTXL;
    bf16_t* prow = proj + (size_t)row * LDP;
    float x1[10], x2[10];
#pragma unroll
    for (int hh = 0; hh < 10; ++hh) {
      const int base = PC_Q + hh * 128 + axis * 64 + pp;
      x1[hh] = bf2f(prow[base]); x2[hh] = bf2f(prow[base + 32]);
    }
    const u32x2 vw = *reinterpret_cast<const u32x2*>(prow + PC_V + lane * 4);
    u32x4 cm[2], cc[2], cp[2], bzv[2];
#pragma unroll
    for (int i = 0; i < 2; ++i) {
      const int c0 = i * 512 + lane * 8;
      const u32x4 z4 = {0u, 0u, 0u, 0u};
      cm[i] = (t > 0) ? *reinterpret_cast<const u32x4*>(prow - LDP + PC_CX + c0) : z4;
      cc[i] = *reinterpret_cast<const u32x4*>(prow + PC_CX + c0);
      cp[i] = (t < slen - 1) ? *reinterpret_cast<const u32x4*>(prow + LDP + PC_CX + c0) : z4;
      bzv[i] = *reinterpret_cast<const u32x4*>(prow + PC_BZ + c0);
    }
    float cs = 1.f, sn = 0.f;
    if (lat) {
      const float pos = (float)(axis == 0 ? (t >> 6) : (t & 63));
      float ang = pos * freq;
      const float n = rintf(ang * 0.15915494309189535f);
      ang = fmaf(n, -6.28318548202514648f, ang); ang = fmaf(n, 1.7484555e-7f, ang);
      cs = __cosf(ang); sn = __sinf(ang);
    }
    const int kpos = lat ? t : SEQ + t;
#pragma unroll
    for (int hh = 0; hh < 10; ++hh) {
      const float ss = wave_sum(x1[hh] * x1[hh] + x2[hh] * x2[hh]);
      const float rs = rsqrtf(ss * (1.f / 128.f) + EPS);
      const float y1 = x1[hh] * rs * (hh < 8 ? g1q : g1k), y2 = x2[hh] * rs * (hh < 8 ? g2q : g2k);
      const bf16_t o1 = f2bf(y1 * cs - y2 * sn), o2 = f2bf(y2 * cs + y1 * sn);
      if (hh < 8) { const int base = PC_Q + hh * 128 + axis * 64 + pp; prow[base] = o1; prow[base + 32] = o2; }
      else { bf16_t* kd = kbuf + ((size_t)(bl * 2 + (hh - 8)) * SKV + kpos) * 128 + axis * 64 + pp; kd[0] = o1; kd[32] = o2; }
    }
    {
      const int kh = lane >> 5, d = (lane & 31) * 4;
      *reinterpret_cast<u32x2*>(vbuf + ((size_t)(bl * 2 + kh) * SKV + kpos) * 128 + d) = vw;
    }
#pragma unroll
    for (int i = 0; i < 2; ++i) {
      const int c0 = i * 512 + lane * 8;
      float o[8];
#pragma unroll
      for (int q = 0; q < 4; ++q) {
        const float wl0 = cwv[i][0][q >> 1][(2 * q) & 3], wh0 = cwv[i][0][q >> 1][(2 * q + 1) & 3];
        const float wl1 = cwv[i][1][q >> 1][(2 * q) & 3], wh1 = cwv[i][1][q >> 1][(2 * q + 1) & 3];
        const float wl2 = cwv[i][2][q >> 1][(2 * q) & 3], wh2 = cwv[i][2][q >> 1][(2 * q + 1) & 3];
        o[2 * q] = bflo(bzv[i][q]) * (wl0 * bflo(cm[i][q]) + wl1 * bflo(cc[i][q]) + wl2 * bflo(cp[i][q]));
        o[2 * q + 1] = bfhi(bzv[i][q]) * (wh0 * bfhi(cm[i][q]) + wh1 * bfhi(cc[i][q]) + wh2 * bfhi(cp[i][q]));
      }
      u32x4 w = {cvtpk(o[0], o[1]), cvtpk(o[2], o[3]), cvtpk(o[4], o[5]), cvtpk(o[6], o[7])};
      *reinterpret_cast<u32x4*>(UA + (size_t)row * 1024 + c0) = w;
    }
  }
}

constexpr int AD = 128, ANW = 8, QBLK = 32, KVBLK = 64;
constexpr float ASCALE = 0.088388347648318440f;
constexpr float ATHR = 8.f;
constexpr int LDQ = LDP, LDK = 128;
constexpr size_t SHM_V = KVBLK * AD * 2, SHM_K = KVBLK * AD * 2;
#define KSWZ(row, colB) ((row) * 256 + ((colB) ^ (((row) & 7) << 4)))
#define SBAR() __builtin_amdgcn_sched_barrier(0)
__device__ __forceinline__ int crow(int r, int hi) { return (r & 3) + 8 * (r >> 2) + 4 * hi; }
__device__ __forceinline__ void partialSM(f32x16& p0, f32x16& p1, float& m_reg, float& mn, float& alpha) {
  constexpr float C = ASCALE * 1.4426950408889634f;
  float pmax = p0[0]; for (int r = 1; r < 16; ++r) pmax = fmaxf(pmax, p0[r]); for (int r = 0; r < 16; ++r) pmax = fmaxf(pmax, p1[r]);
  { auto rr = __builtin_amdgcn_permlane32_swap(__float_as_uint(pmax), __float_as_uint(pmax), false, false);
    pmax = fmaxf(__uint_as_float(rr[0]), __uint_as_float(rr[1])); }
  if (__builtin_expect(__all(pmax - m_reg <= ATHR / ASCALE), 1)) { mn = m_reg; alpha = 1.f; }
  else { mn = fmaxf(m_reg, pmax); alpha = __builtin_amdgcn_exp2f((m_reg - mn) * C); m_reg = mn; }
  float mnC = -mn * C;
  for (int r = 0; r < 16; ++r) p0[r] = fmaf(p0[r], C, mnC); for (int r = 0; r < 16; ++r) p1[r] = fmaf(p1[r], C, mnC);
  for (int r = 0; r < 16; ++r) p0[r] = __builtin_amdgcn_exp2f(p0[r]);
}
__device__ __forceinline__ void finishSM(f32x16& p0, f32x16& p1, float alpha, float& l_reg, bf16x8& pa0, bf16x8& pa1, bf16x8& pa2, bf16x8& pa3) {
  for (int r = 0; r < 16; ++r) p1[r] = __builtin_amdgcn_exp2f(p1[r]);
  float ps = 0; for (int r = 0; r < 16; ++r) ps += p0[r]; for (int r = 0; r < 16; ++r) ps += p1[r];
  { auto rr = __builtin_amdgcn_permlane32_swap(__float_as_uint(ps), __float_as_uint(ps), false, false);
    ps = __uint_as_float(rr[0]) + __uint_as_float(rr[1]); }
  l_reg = l_reg * alpha + ps;
#define PK4(P, BASE, OUT) do { unsigned a0 = cvtpk(P[BASE + 0], P[BASE + 1]), a1 = cvtpk(P[BASE + 2], P[BASE + 3]);   \
    unsigned b0 = cvtpk(P[BASE + 4], P[BASE + 5]), b1 = cvtpk(P[BASE + 6], P[BASE + 7]);                              \
    auto r0 = __builtin_amdgcn_permlane32_swap(a0, b0, false, false); auto r1 = __builtin_amdgcn_permlane32_swap(a1, b1, false, false); \
    u32x4 w = {r0[0], r1[0], r0[1], r1[1]}; OUT = *reinterpret_cast<bf16x8*>(&w); } while (0)
  PK4(p0, 0, pa0); PK4(p0, 8, pa1); PK4(p1, 0, pa2); PK4(p1, 8, pa3);
#undef PK4
}
__device__ __forceinline__ void qkt(f32x16& p0, f32x16& p1, const bf16_t* Ks, const bf16x8* qr, int r32, int hi) {
  p0 = f32x16{}; p1 = f32x16{};
  for (int d0 = 0; d0 < 8; ++d0) { int cb = (d0 * 16 + hi * 8) * 2;
    bf16x8 b0 = *reinterpret_cast<const bf16x8*>((const char*)Ks + KSWZ(r32, cb));
    bf16x8 b1 = *reinterpret_cast<const bf16x8*>((const char*)Ks + KSWZ(32 + r32, cb));
    p0 = __builtin_amdgcn_mfma_f32_32x32x16_bf16(b0, qr[d0], p0, 0, 0, 0);
    p1 = __builtin_amdgcn_mfma_f32_32x32x16_bf16(b1, qr[d0], p1, 0, 0, 0); }
}
__device__ __forceinline__ int v_st(int k, int c) { const int kk = (k & ~0xC) | ((k & 4) << 1) | ((k & 8) >> 1); return ((kk >> 3) * 4 + (c >> 5)) * 512 + ((kk & 7) * 32 + (c & 31)) * 2; }
__device__ __forceinline__ int v_rd_base(int lane) { return ((lane & 3) << 3) | (((lane >> 2) & 3) << 6) | (((lane >> 4) & 1) << 5) | (((lane >> 5) & 1) << 8); }
constexpr int v_rd_off(int d0, int ks, int half) { return d0 * 512 + ks * 4096 + half * 2048; }
template <int OFF> __device__ __forceinline__ s16x4 tr_read(int vb) {
  s16x4 r; asm volatile("ds_read_b64_tr_b16 %0, %1 offset:%2" : "=&v"(r) : "v"(vb), "i"(OFF) : "memory"); return r;
}
template <int D0> __device__ __forceinline__ void pv_one(f32x16& od, int vb, bf16x8 pa0, bf16x8 pa1, bf16x8 pa2, bf16x8 pa3) {
  const s16x4 l0 = tr_read<v_rd_off(D0, 0, 0)>(vb), h0 = tr_read<v_rd_off(D0, 0, 1)>(vb), l1 = tr_read<v_rd_off(D0, 1, 0)>(vb), h1 = tr_read<v_rd_off(D0, 1, 1)>(vb);
  const s16x4 l2 = tr_read<v_rd_off(D0, 2, 0)>(vb), h2 = tr_read<v_rd_off(D0, 2, 1)>(vb), l3 = tr_read<v_rd_off(D0, 3, 0)>(vb), h3 = tr_read<v_rd_off(D0, 3, 1)>(vb);
  asm volatile("s_waitcnt lgkmcnt(0)" ::: "memory"); SBAR();
#define PK(L, H) (bf16x8){L[0], L[1], L[2], L[3], H[0], H[1], H[2], H[3]}
  od = __builtin_amdgcn_mfma_f32_32x32x16_bf16(pa0, PK(l0, h0), od, 0, 0, 0);
  od = __builtin_amdgcn_mfma_f32_32x32x16_bf16(pa1, PK(l1, h1), od, 0, 0, 0);
  od = __builtin_amdgcn_mfma_f32_32x32x16_bf16(pa2, PK(l2, h2), od, 0, 0, 0);
  od = __builtin_amdgcn_mfma_f32_32x32x16_bf16(pa3, PK(l3, h3), od, 0, 0, 0);
#undef PK
}
__device__ __forceinline__ void pv_d0(f32x16* o, int vb, bf16x8 pa0, bf16x8 pa1, bf16x8 pa2, bf16x8 pa3) {
  pv_one<0>(o[0], vb, pa0, pa1, pa2, pa3); pv_one<1>(o[1], vb, pa0, pa1, pa2, pa3); pv_one<2>(o[2], vb, pa0, pa1, pa2, pa3); pv_one<3>(o[3], vb, pa0, pa1, pa2, pa3);
}
__device__ __forceinline__ void attn_dense_body(const bf16_t* __restrict__ Qb, const bf16_t* __restrict__ Kh, const bf16_t* __restrict__ Vh,
                                                bf16_t* __restrict__ Ob, const bf16_t* __restrict__ Zb, int seq, char* lds) {
  constexpr int SDEPTH = 2;
  int tid_ = threadIdx.x; asm volatile("" : "+v"(tid_)); const int tid = tid_, wid = tid >> 6, lane = tid & 63, r32 = lane & 31, hi = lane >> 5;
  bf16_t* V_lds = (bf16_t*)lds; bf16_t* K_lds = (bf16_t*)(lds + 2 * SHM_V);
  float* ws = (float*)(lds + 2 * SHM_V + 2 * SHM_K) + wid * 64; float* li_l = ws; float* al_l = ws + 32;
  float m_reg = -1e30f, l_reg = 0; f32x16 o[4] = {}; bf16x8 qr[8];
  const bf16_t* Qw = Qb + (long)(wid * QBLK + r32) * LDQ + hi * 8;
#pragma unroll
  for (int d0 = 0; d0 < 8; ++d0) qr[d0] = *reinterpret_cast<const bf16x8*>(Qw + d0 * 16);
  const int sr = tid >> 4, sc = (tid & 15) * 8, vst0 = v_st(sr, sc), vst1 = v_st(32 + sr, sc);
  const int vb0 = (int)(uintptr_t)V_lds + v_rd_base(lane);
  struct { bf16x8 vs0, vs1, ks0, ks1; } sr_[SDEPTH];
#define SLOAD(i, k0) do { sr_[i].vs0 = *reinterpret_cast<const bf16x8*>(&Vh[(long)((k0) + sr) * LDK + sc]); sr_[i].vs1 = *reinterpret_cast<const bf16x8*>(&Vh[(long)((k0) + 32 + sr) * LDK + sc]); \
    sr_[i].ks0 = *reinterpret_cast<const bf16x8*>(&Kh[(long)((k0) + sr) * LDK + sc]); sr_[i].ks1 = *reinterpret_cast<const bf16x8*>(&Kh[(long)((k0) + 32 + sr) * LDK + sc]); } while (0)
#define SWRITE(b, i) do { *(bf16x8*)((char*)V_lds + (b) * SHM_V + vst0) = sr_[i].vs0;          \
    *(bf16x8*)((char*)V_lds + (b) * SHM_V + vst1) = sr_[i].vs1; int kc = sc * 2;               \
    *(bf16x8*)((char*)K_lds + (b) * SHM_K + KSWZ(sr, kc)) = sr_[i].ks0;                       \
    *(bf16x8*)((char*)K_lds + (b) * SHM_K + KSWZ(32 + sr, kc)) = sr_[i].ks1; } while (0)
#define SWAIT() do { asm volatile("s_waitcnt vmcnt(4)" ::: "memory"); } while (0)
#define RESC(a) do { if (__any((a) < 1.f)) { if (hi == 0) al_l[r32] = (a); asm volatile("s_waitcnt lgkmcnt(0)" ::: "memory"); \
    for (int d = 0; d < 4; ++d) for (int r = 0; r < 16; ++r) o[d][r] *= al_l[crow(r, hi)]; } } while (0)
  f32x16 pA0, pA1, pB0, pB1; float mnA, mnB, alA, alB; bf16x8 pa0, pa1, pa2, pa3; const int NT = seq / KVBLK;
  constexpr int SE = 0, SO = SDEPTH - 1;
  SLOAD(SE, 0); asm volatile("s_waitcnt vmcnt(0)" ::: "memory"); SWRITE(0, SE); __syncthreads();
  qkt(pA0, pA1, K_lds, qr, r32, hi); partialSM(pA0, pA1, m_reg, mnA, alA);
  SLOAD(SO, KVBLK); if (2 < NT) SLOAD(SE, 2 * KVBLK);
  SWAIT(); SWRITE(1, SO); __syncthreads();
  for (int j = 1; j + 1 < NT; j += 2) {
    SBAR(); qkt(pB0, pB1, (bf16_t*)((char*)K_lds + SHM_K), qr, r32, hi);
    finishSM(pA0, pA1, alA, l_reg, pa0, pa1, pa2, pa3); SBAR();
    SLOAD(SO, (j + SDEPTH) * KVBLK); SBAR();
    pv_d0(o, vb0, pa0, pa1, pa2, pa3); partialSM(pB0, pB1, m_reg, mnB, alB);
    __syncthreads(); SWAIT(); SWRITE(0, SE);
    RESC(alB); __syncthreads();
    SBAR(); qkt(pA0, pA1, K_lds, qr, r32, hi);
    finishSM(pB0, pB1, alB, l_reg, pa0, pa1, pa2, pa3); SBAR();
    if (j + 3 < NT) SLOAD(SE, (j + 1 + SDEPTH) * KVBLK); SBAR();
    pv_d0(o, vb0 + (int)SHM_V, pa0, pa1, pa2, pa3); partialSM(pA0, pA1, m_reg, mnA, alA);
    __syncthreads(); SWAIT(); SWRITE(1, SO);
    RESC(alA); __syncthreads();
  }
  SBAR(); qkt(pB0, pB1, (bf16_t*)((char*)K_lds + SHM_K), qr, r32, hi);
  finishSM(pA0, pA1, alA, l_reg, pa0, pa1, pa2, pa3); SBAR();
  pv_d0(o, vb0, pa0, pa1, pa2, pa3); partialSM(pB0, pB1, m_reg, mnB, alB);
  __syncthreads(); RESC(alB);
  finishSM(pB0, pB1, alB, l_reg, pa0, pa1, pa2, pa3); SBAR();
  pv_d0(o, vb0 + (int)SHM_V, pa0, pa1, pa2, pa3);
  if (hi == 0) li_l[r32] = l_reg; asm volatile("s_waitcnt lgkmcnt(0)" ::: "memory");
  float rli[16];
#pragma unroll
  for (int r = 0; r < 16; ++r) rli[r] = __builtin_amdgcn_rcpf(li_l[crow(r, hi)]);
  bf16_t* Ow = Ob + (long)(wid * QBLK) * 1024;
  const bf16_t* Zw = Zb + (long)(wid * QBLK) * LDP;
#pragma unroll
  for (int r = 0; r < 16; ++r) { int orow = crow(r, hi);
    for (int d0 = 0; d0 < 4; ++d0) Ow[(long)orow * 1024 + d0 * 32 + r32] = f2bf(o[d0][r] * rli[r] * bf2f(Zw[(long)orow * LDP + d0 * 32 + r32])); }
  __syncthreads();
#undef SLOAD
#undef SWRITE
#undef SWAIT
#undef RESC
}
__device__ __forceinline__ void attn_item(const Params& p, int a) {
  const bf16_t* proj = (const bf16_t*)(p.ws + WS_PROJ);
  const bf16_t* kbuf = (const bf16_t*)(p.ws + WS_KBUF); const bf16_t* vbuf = (const bf16_t*)(p.ws + WS_VBUF);
  bf16_t* UB = (bf16_t*)(p.ws + WS_UB);
  int bl, h, row0, k0, seq;
  if (a < 256) { bl = a >> 7; h = (a >> 4) & 7; row0 = bl * SEQ + (a & 15) * 256; k0 = 0; seq = SKV; }
  else { const int i = a - 256; bl = i >> 3; h = i & 7; row0 = NLAT + bl * CTXL; k0 = SEQ; seq = CTXL; }
  const size_t kvo = ((size_t)(bl * 2 + (h >> 2)) * SKV + k0) * 128;
  attn_dense_body(proj + (size_t)row0 * LDP + PC_Q + h * 128, kbuf + kvo, vbuf + kvo, UB + (size_t)row0 * 1024 + h * 128,
                  proj + (size_t)row0 * LDP + PC_ZA + h * 128, seq, smem);
}

constexpr int GQS = 136, GTS = 72, GDV = 32;
constexpr int G_QS = 0, G_KS = 64 * GQS, G_KST = 2 * 64 * GQS, G_VST = G_KST + 128 * GTS, G_STAGE = G_VST + GDV * GTS;
constexpr int G_AS = 2 * G_STAGE, G_STS = G_AS + 64 * GTS, G_END = G_STS + GDV * GQS;
static_assert(G_END * 2 <= SMEM_MAIN, "GLA LDS");
__device__ __forceinline__ void gla_item(const Params& p, int item) {
  int tid_ = threadIdx.x; asm volatile("" : "+v"(tid_)); const int tid = tid_, w = tid >> 6, lane = tid & 63, lr = lane & 15, lq = lane >> 4;
  const int dvs = item & 7, dir = (item >> 3) & 1, head = (item >> 4) & 3, bl = item >> 6;
  const bf16_t* QT = (const bf16_t*)(p.ws + WS_QT) + (size_t)dir * GROWS * 512 + head * 128;
  const bf16_t* KT = (const bf16_t*)(p.ws + WS_KT) + (size_t)dir * GROWS * 512 + head * 128;
  const bf16_t* KTT = (const bf16_t*)(p.ws + WS_KTT) + ((size_t)dir * 136 * 512 + head * 128) * 64;
  const bf16_t* VT = (const bf16_t*)(p.ws + WS_VT) + (size_t)(head * 256 + dvs * GDV) * GROWS;
  const float* E = (const float*)(p.ws + WS_E) + (size_t)dir * 136 * 512 + head * 128 + w * 16 + lq * 4;
  bf16_t* OG = (bf16_t*)(p.ws + WS_OG) + (size_t)dir * GROWS * 1024 + head * 256 + dvs * GDV;
  bf16_t* L = (bf16_t*)smem;
  bf16_t* As = L + G_AS; bf16_t* STs = L + G_STS;
  const int srow = tid >> 3, scol = (tid & 7) * 16, vcol = (tid & 7) * 8, trow = tid >> 2, tcol = (tid & 3) * 16;
  const bool vld = tid < 256;
  f32x4 S[2];
#pragma unroll
  for (int i = 0; i < 2; ++i) S[i] = f32x4{0.f, 0.f, 0.f, 0.f};
  for (int i = tid; i < GDV * GQS / 2; i += 512) ((unsigned*)STs)[i] = 0u;
  struct Regs { u32x4 q0, q1, k0, k1, t0, t1, v0; };
  Regs RA, RB; f32x4 eA, eB;
  RA.v0 = u32x4{0u, 0u, 0u, 0u}; RB.v0 = RA.v0;
  auto chunk_row0 = [&](int c) -> int {
    if (c < 4) { const int cc = dir ? 3 - c : c; return NLAT + bl * CTXL + cc * 64; }
    const int cc = dir ? 63 - (c - 4) : (c - 4); return bl * SEQ + cc * 64;
  };
  auto gload = [&](int c, Regs& r) {
    const int r0_ = chunk_row0(c); const size_t r_ = (size_t)(r0_ + srow);
    r.q0 = *reinterpret_cast<const u32x4*>(QT + r_ * 512 + scol); r.q1 = *reinterpret_cast<const u32x4*>(QT + r_ * 512 + scol + 8);
    r.k0 = *reinterpret_cast<const u32x4*>(KT + r_ * 512 + scol); r.k1 = *reinterpret_cast<const u32x4*>(KT + r_ * 512 + scol + 8);
    const bf16_t* tp_ = KTT + ((size_t)(r0_ >> 6) * 512 + trow) * 64 + tcol;
    r.t0 = *reinterpret_cast<const u32x4*>(tp_); r.t1 = *reinterpret_cast<const u32x4*>(tp_ + 8);
    if (vld) r.v0 = *reinterpret_cast<const u32x4*>(VT + (size_t)srow * GROWS + r0_ + vcol);
  };
  auto gstore = [&](int bsel, const Regs& r) {
    bf16_t* b_ = L + bsel * G_STAGE;
    *reinterpret_cast<u32x4*>(b_ + G_QS + srow * GQS + scol) = r.q0; *reinterpret_cast<u32x4*>(b_ + G_QS + srow * GQS + scol + 8) = r.q1;
    *reinterpret_cast<u32x4*>(b_ + G_KS + srow * GQS + scol) = r.k0; *reinterpret_cast<u32x4*>(b_ + G_KS + srow * GQS + scol + 8) = r.k1;
    *reinterpret_cast<u32x4*>(b_ + G_KST + trow * GTS + tcol) = r.t0; *reinterpret_cast<u32x4*>(b_ + G_KST + trow * GTS + tcol + 8) = r.t1;
    if (vld) *reinterpret_cast<u32x4*>(b_ + G_VST + srow * GTS + vcol) = r.v0;
  };
  auto eload = [&](int c) -> f32x4 { return *reinterpret_cast<const f32x4*>(E + (size_t)(chunk_row0(c) >> 6) * 512); };
  gload(0, RA); gstore(0, RA); gload(1, RA); gload(2, RB);
  eA = eload(0); eB = eA;
  __syncthreads();
  const int tr = w >> 1, tc0 = (w & 1) * 2, tco = w & 1;
  auto step = [&](int c, Regs& RX, const f32x4& eCur, f32x4& eNext) {
    const int row0 = chunk_row0(c);
    const bf16_t* B = L + (c & 1) * G_STAGE;
    bf16x8 qf[4];
    gstore((c + 1) & 1, RX);
    gload(c + 3 < 68 ? c + 3 : 67, RX);
    eNext = eload(c + 1 < 68 ? c + 1 : 67);
    {
      f32x4 a0 = {0.f, 0.f, 0.f, 0.f}, a1 = {0.f, 0.f, 0.f, 0.f};
#pragma unroll
      for (int kk = 0; kk < 4; ++kk) {
        qf[kk] = *reinterpret_cast<const bf16x8*>(B + G_QS + (tr * 16 + lr) * GQS + kk * 32 + lq * 8);
        const bf16x8 b0 = *reinterpret_cast<const bf16x8*>(B + G_KS + (tc0 * 16 + lr) * GQS + kk * 32 + lq * 8);
        const bf16x8 b1 = *reinterpret_cast<const bf16x8*>(B + G_KS + ((tc0 + 1) * 16 + lr) * GQS + kk * 32 + lq * 8);
        a0 = __builtin_amdgcn_mfma_f32_16x16x32_bf16(b0, qf[kk], a0, 0, 0, 0);
        a1 = __builtin_amdgcn_mfma_f32_16x16x32_bf16(b1, qf[kk], a1, 0, 0, 0);
      }
      const int t = tr * 16 + lr;
#pragma unroll
      for (int j = 0; j < 4; ++j) {
        const int s0 = tc0 * 16 + lq * 4 + j, s1 = s0 + 16;
        const bool m0 = dir ? (s0 >= t) : (s0 <= t), m1 = dir ? (s1 >= t) : (s1 <= t);
        a0[j] = m0 ? a0[j] : 0.f; a1[j] = m1 ? a1[j] : 0.f;
      }
      u32x2 w0 = {cvtpk(a0[0], a0[1]), cvtpk(a0[2], a0[3])}, w1 = {cvtpk(a1[0], a1[1]), cvtpk(a1[2], a1[3])};
      *reinterpret_cast<u32x2*>(As + t * GTS + tc0 * 16 + lq * 4) = w0;
      *reinterpret_cast<u32x2*>(As + t * GTS + (tc0 + 1) * 16 + lq * 4) = w1;
    }
    __syncthreads();
    {
      f32x4 o0 = {0.f, 0.f, 0.f, 0.f};
#pragma unroll
      for (int kk = 0; kk < 2; ++kk) {
        const bf16x8 af = *reinterpret_cast<const bf16x8*>(As + (tr * 16 + lr) * GTS + kk * 32 + lq * 8);
        const bf16x8 b0 = *reinterpret_cast<const bf16x8*>(B + G_VST + (tco * 16 + lr) * GTS + kk * 32 + lq * 8);
        o0 = __builtin_amdgcn_mfma_f32_16x16x32_bf16(b0, af, o0, 0, 0, 0);
      }
#pragma unroll
      for (int kk = 0; kk < 4; ++kk) {
        const bf16x8 b0 = *reinterpret_cast<const bf16x8*>(STs + (tco * 16 + lr) * GQS + kk * 32 + lq * 8);
        o0 = __builtin_amdgcn_mfma_f32_16x16x32_bf16(b0, qf[kk], o0, 0, 0, 0);
      }
      {
        bf16_t* op = OG + (size_t)(row0 + tr * 16 + lr) * 1024 + tco * 16 + lq * 4;
        u32x2 w0 = {cvtpk(o0[0], o0[1]), cvtpk(o0[2], o0[3])};
        *reinterpret_cast<u32x2*>(op) = w0;
      }
#pragma unroll
      for (int kk = 0; kk < 2; ++kk) {
        const bf16x8 af = *reinterpret_cast<const bf16x8*>(B + G_KST + (w * 16 + lr) * GTS + kk * 32 + lq * 8);
#pragma unroll
        for (int tc = 0; tc < 2; ++tc) {
          const bf16x8 bfr = *reinterpret_cast<const bf16x8*>(B + G_VST + (tc * 16 + lr) * GTS + kk * 32 + lq * 8);
          S[tc] = __builtin_amdgcn_mfma_f32_16x16x32_bf16(af, bfr, S[tc], 0, 0, 0);
        }
      }
#pragma unroll
      for (int tc = 0; tc < 2; ++tc) S[tc] *= eCur;
    }
    __syncthreads();
#pragma unroll
    for (int tc = 0; tc < 2; ++tc) {
      u32x2 wv = {cvtpk(S[tc][0], S[tc][1]), cvtpk(S[tc][2], S[tc][3])};
      *reinterpret_cast<u32x2*>(STs + (tc * 16 + lr) * GQS + w * 16 + lq * 4) = wv;
    }
  };
#pragma unroll 1
  for (int c = 0; c < 68; c += 2) { step(c, RA, eA, eB); step(c + 1, RB, eB, eA); }
  __syncthreads();
}

__device__ __forceinline__ void glapost_rows(const Params& p, int l) {
  int tid_ = threadIdx.x; asm volatile("" : "+v"(tid_)); const int tid = tid_, wave = tid >> 6, lane = tid & 63;
  const bf16_t* OG0 = (const bf16_t*)(p.ws + WS_OG); const bf16_t* OG1 = OG0 + (size_t)GROWS * 1024;
  const bf16_t* proj = (const bf16_t*)(p.ws + WS_PROJ);
  bf16_t* UC = (bf16_t*)(p.ws + WS_UC);
  const int nrows = l == 0 ? GROWS : NLAT;
  const float* gg = p.gla_g + l * 256 + (lane & 15) * 16;
  const int ntile = (nrows / 256) * 4, nrb = (int)gridDim.x - ntile;
  for (int row = ((int)blockIdx.x - ntile) * 8 + wave; row < nrows; row += nrb * 8) {
    const size_t o = (size_t)row * 1024 + lane * 16;
    float v[16]; float ss = 0.f;
#pragma unroll
    for (int i = 0; i < 2; ++i) {
      const u32x4 a = *reinterpret_cast<const u32x4*>(OG0 + o + i * 8), b = *reinterpret_cast<const u32x4*>(OG1 + o + i * 8);
#pragma unroll
      for (int q = 0; q < 4; ++q) { v[i * 8 + 2 * q] = bflo(a[q]) + bflo(b[q]); v[i * 8 + 2 * q + 1] = bfhi(a[q]) + bfhi(b[q]); }
    }
#pragma unroll
    for (int i = 0; i < 16; ++i) ss += v[i] * v[i];
#pragma unroll
    for (int s = 8; s >= 1; s >>= 1) ss += __shfl_xor(ss, s, 64);
    const float rs = rsqrtf(ss * (1.f / 256.f) + EPS);
#pragma unroll
    for (int i = 0; i < 2; ++i) {
      const u32x4 z = *reinterpret_cast<const u32x4*>(proj + (size_t)row * LDP + PC_ZG + lane * 16 + i * 8);
      float r[8];
#pragma unroll
      for (int q = 0; q < 4; ++q) {
        r[2 * q] = v[i * 8 + 2 * q] * rs * gg[i * 8 + 2 * q] * bflo(z[q]);
        r[2 * q + 1] = v[i * 8 + 2 * q + 1] * rs * gg[i * 8 + 2 * q + 1] * bfhi(z[q]);
      }
      u32x4 wv = {cvtpk(r[0], r[1]), cvtpk(r[2], r[3]), cvtpk(r[4], r[5]), cvtpk(r[6], r[7])};
      *reinterpret_cast<u32x4*>(UC + o + i * 8) = wv;
    }
  }
}

__device__ __forceinline__ void merge_tile(const Params& p, int l, int pm, int pn, int br) {
  EpiMerge epi; epi.gate = (const bf16_t*)(p.ws + WS_PROJ) + PC_MG + br * 1024;
  epi.M = (bf16_t*)(p.ws + WS_M); epi.br = br;
  const bf16_t* Ab = (const bf16_t*)(p.ws + (br == 0 ? WS_UA : (br == 1 ? WS_UB : WS_UC)));
  const bf16_t* W = (const bf16_t*)(p.ws + WS_WTBR) + (size_t)(l * 3 + br) * 1024 * 1024;
  gemm_tile(Ab, W, 1024, pm * 256, pn * 256, epi);
}
__device__ __forceinline__ void merge_phase(const Params& p, int l) {
  const int nM = (l == 0 ? GROWS : NLAT) / 256, nN = 4;
  for (int i = 0;; ++i) {
    int pm, pn; if (!tile_of(i * gridDim.x + blockIdx.x, nM, nN, pm, pn)) break;
#pragma unroll 1
    for (int br = 2; br < 3; ++br) merge_tile(p, l, pm, pn, br);
  }
}
__device__ __forceinline__ void out_phase(const Params& p, int l) {
  const bf16_t* M = (const bf16_t*)(p.ws + WS_M);
  const bf16_t* W = (const bf16_t*)(p.ws + WS_WTOUT) + (size_t)l * 1024 * 1024;
  EpiOutF epi; epi.O = (bf16_t*)(p.ws + WS_OUTF);
  const int nM = (l == 0 ? GROWS : NLAT) / 256, nN = 4;
  for (int i = 0;; ++i) {
    int pm, pn; if (!tile_of(i * gridDim.x + blockIdx.x, nM, nN, pm, pn)) break;
    gemm_tile(M, W, 1024, pm * 256, pn * 256, epi);
  }
}


#ifndef DBG_STOP
#define DBG_STOP 0
#define DBG_WHICH 4
#endif
__device__ __forceinline__ void dbg_dump(const Params& p, int which) {
  const size_t n_out = (size_t)NB * SEQ * DM;
  const size_t gtid = (size_t)blockIdx.x * 512 + threadIdx.x, gsz = (size_t)gridDim.x * 512;
  if (which == 1) {
    const bf16_t* UB = (const bf16_t*)(p.ws + WS_UB); const bf16_t* OG = (const bf16_t*)(p.ws + WS_OG);
    const size_t n1 = (size_t)GROWS * 1024, n2 = (size_t)2 * GROWS * 1024;
    for (size_t i = gtid; i < n_out; i += gsz) {
      float v = 0.f;
      if (i < n1) v = bf2f(UB[i]);
      p.out[i] = v;
    }
  } else if (which == 4) {
    const bf16_t* QT = (const bf16_t*)(p.ws + WS_QT); const bf16_t* KT = (const bf16_t*)(p.ws + WS_KT); const float* E = (const float*)(p.ws + WS_E);
    const size_t n1 = (size_t)2 * GROWS * 512, n2 = (size_t)GROWS * 512 + 200000, n3 = (size_t)2 * 136 * 512;
    for (size_t i = gtid; i < n_out; i += gsz) {
      float v = 0.f;
      if (i < n1) v = bf2f(QT[i]); else if (i < n1 + n2) v = bf2f(KT[i - n1]); else if (i < n1 + n2 + n3) v = E[i - n1 - n2];
      p.out[i] = v;
    }
  } else if (which == 2) {
    const bf16_t* proj = (const bf16_t*)(p.ws + WS_PROJ);
    const size_t n1 = (size_t)3000 * LDP;
    for (size_t i = gtid; i < n_out; i += gsz) p.out[i] = i < n1 ? bf2f(proj[i]) : 0.f;
  } else {
    const bf16_t* outf = (const bf16_t*)(p.ws + WS_OUTF);
    const size_t n1 = (size_t)GROWS * 1024;
    for (size_t i = gtid; i < n_out; i += gsz) p.out[i] = i < n1 ? outf[i] : 0.f;
  }
}


#define XB_TMO      128
#define XB_XCNT(j)  (256  + 64 * (j))
#define XB_XSUB(j)  (1280 + 64 * (j))
#define XB_XGEN(j)  (2304 + 64 * (j))
#define XB_TOP      3328
#define XB_TOPGEN   3392
#define XCD_BAR_WORDS 3456
#define XB_SPIN_CAP (1u << 18)
__device__ __forceinline__ unsigned xb_ld(unsigned* p)              { return __hip_atomic_load(p, __ATOMIC_RELAXED, __HIP_MEMORY_SCOPE_AGENT); }
__device__ __forceinline__ unsigned xb_add(unsigned* p, unsigned v) { return __hip_atomic_fetch_add(p, v, __ATOMIC_RELAXED, __HIP_MEMORY_SCOPE_AGENT); }
__device__ __forceinline__ unsigned xb_xcc_id() { return (unsigned)__builtin_amdgcn_s_getreg((3 << 11) | 20) & 0xFu; }
#define XB_SPIN(cond, bar) do { unsigned _sp = 0; while (cond) { __builtin_amdgcn_s_sleep(1); \
    if ((++_sp & 255u) == 0u) { if (xb_ld(&(bar)[XB_TMO])) break; if (_sp > XB_SPIN_CAP) { atomicAdd(&(bar)[XB_TMO], 1u); break; } } } } while (0)
struct XcdBarrier { unsigned* bar; unsigned x; volatile LAS unsigned* st; };
__device__ __forceinline__ XcdBarrier xcd_barrier_post(unsigned* bar, volatile LAS unsigned* st) {
  XcdBarrier b; b.bar = bar; b.x = xb_xcc_id(); b.st = st;
  if (threadIdx.x == 0) (void)xb_add(&bar[XB_XCNT(b.x)], 1u);
  return b;
}
__device__ __forceinline__ void xcd_barrier_complete(unsigned* bar, unsigned x, unsigned& nloc, unsigned& nx) {
  const unsigned G = gridDim.x * gridDim.y * gridDim.z;
  unsigned sum, cnt, mine, sp = 0u;
  for (;;) {
    sum = 0u; cnt = 0u; mine = 0u;
#pragma unroll
    for (unsigned j = 0; j < 16; ++j) { const unsigned c = xb_ld(&bar[XB_XCNT(j)]); sum += c; cnt += (c > 0u) ? 1u : 0u; mine = (j == x) ? c : mine; }
    if (sum == G) break;
    __builtin_amdgcn_s_sleep(1);
    if ((++sp & 255u) == 0u) { if (xb_ld(&bar[XB_TMO])) break; if (sp > XB_SPIN_CAP) { atomicAdd(&bar[XB_TMO], 1u); break; } }
  }
  nloc = mine > 0u ? mine : 1u; nx = cnt > 0u ? cnt : 1u;
}
__device__ __forceinline__ void xcd_barrier(const XcdBarrier& b) {
  asm volatile("s_waitcnt vmcnt(0)" ::: "memory");
  __syncthreads();
  if (threadIdx.x == 0) {
    unsigned* bar = b.bar;
    __builtin_amdgcn_s_waitcnt(0);
    unsigned nloc = b.st[0], nx = b.st[1];
    if (nloc == 0u) { xcd_barrier_complete(bar, b.x, nloc, nx); b.st[0] = nloc; b.st[1] = nx; }
    const unsigned old = xb_add(&bar[XB_XSUB(b.x)], 1u);
    const unsigned gen = old / nloc;
    if (old + 1u == (gen + 1u) * nloc) {
      __builtin_amdgcn_fence(__ATOMIC_RELEASE, "agent");
      asm volatile("s_waitcnt vmcnt(0)" ::: "memory");
      const unsigned og = xb_add(&bar[XB_TOP], 1u);
      const unsigned tg = og / nx;
      if (og + 1u == (tg + 1u) * nx) xb_add(&bar[XB_TOPGEN], 1u);
      else XB_SPIN(xb_ld(&bar[XB_TOPGEN]) == tg, bar);
      __builtin_amdgcn_fence(__ATOMIC_ACQUIRE, "agent");
      xb_add(&bar[XB_XGEN(b.x)], 1u);
      asm volatile("s_waitcnt vmcnt(0)" ::: "memory");
    } else {
      XB_SPIN(xb_ld(&bar[XB_XGEN(b.x)]) == gen, bar);
      __builtin_amdgcn_fence(__ATOMIC_ACQUIRE, "agent");
      asm volatile("s_waitcnt vmcnt(0)" ::: "memory");
    }
  }
  __syncthreads();
}

__device__ __forceinline__ void glapost_phase(const Params& p, int l) {
  const int nM = (l == 0 ? GROWS : NLAT) / 256, ntile = nM * 4;
  if ((int)blockIdx.x < ntile) { int pm, pn; tile_of(blockIdx.x, nM, 4, pm, pn); merge_tile(p, l, pm, pn, 1); }
  else glapost_rows(p, l);
}
__device__ __forceinline__ void mix_phase(const Params& p, int l) {
  const int natt = (l == 0) ? 272 : 256;
  const int nM = (l == 0 ? GROWS : NLAT) / 256, nmerge = nM * 4, nctx = natt - 256, ndef = nM * (l == 0 ? 6 : 4), nextra = nmerge + nctx + ndef;
  const int b = blockIdx.x;
  for (int k = 0;; ++k) {
    int type, idx;
    if (b < 128) { if (k == 0) { type = 0; idx = ((((b & 7) << 1) | (b >> 6)) << 3) | ((b >> 3) & 7); } else if (k == 1) { type = 1; idx = 128 + ((((b & 1) << 2) | ((b >> 3) & 3)) << 4) + (((b & 7) >> 1) << 2) + (b >> 5); } else break; }
    else if (b < 256) {
      if (k == 0) { const int c = b - 128; type = 1; idx = ((((c & 1) << 2) | ((c >> 3) & 3)) << 4) + (((c & 7) >> 1) << 2) + (c >> 5); }
      else { const int e = (b - 128) + (k - 1) * 128; if (e >= nextra) break;
        if (e < nmerge) { type = 2; idx = e; } else if (e < nmerge + nctx) { type = 1; idx = 256 + e - nmerge; } else { type = 3; idx = e - nmerge - nctx; } }
    } else break;
    if (type == 0) gla_item(p, idx);
    else if (type == 1) attn_item(p, idx);
    else if (type == 2) { int pm, pn; tile_of(idx, nM, 4, pm, pn); merge_tile(p, l, pm, pn, 0); }
    else inproj_deferred_tile(p, l, idx, ndef);
  }
}

constexpr int NPHASE = 1 + 4 * 15;
__device__ __forceinline__ void run_phase(const Params& p, int ph) {
  if (ph == 0) { phase0(p); return; }
  const int q = ph - 1, g = q / 15, r = q % 15;
  if (r == 14) { norm_phase(p, g, 2); return; }
  if (r == 0 && g > 0) return;
  const int l = r / 7, s = r % 7;
  switch (s) {
    case 0: norm_phase(p, g, l); break;
    case 1: inproj_phase(p, l); break;
    case 2: prep_phase(p, l); break;
    case 3: mix_phase(p, l); break;
    case 4: glapost_phase(p, l); break;
    case 5: merge_phase(p, l); break;
    default: out_phase(p, l);
      if (l == 1 && g < 3 && (int)gridDim.x > 128) {
        if ((int)blockIdx.x >= 128) norm_rows(p, g + 1, 0, 0, GROWS, (int)blockIdx.x - 128, (int)gridDim.x - 128);
      } else if (l == 1 && g < 3) norm_phase(p, g + 1, 0);
      break;
  }
}

__global__ void __launch_bounds__(512) mega(Params p, int ph_lo, int ph_hi, int coop) {
  volatile LAS unsigned* st = (volatile LAS unsigned*)((LAS unsigned char*)smem + SMEM_MAIN);
  XcdBarrier xb; xb.bar = (unsigned*)(p.ws + WS_BAR); xb.x = 0; xb.st = st;
  if (coop) {
    if (threadIdx.x < 4) st[threadIdx.x] = 0u;
    __syncthreads();
    xb = xcd_barrier_post((unsigned*)(p.ws + WS_BAR), st);
  }
  for (int ph = ph_lo; ph < ph_hi; ++ph) {
    if (ph > 15 && (ph - 1) % 15 == 0) continue;
    run_phase(p, ph);
    if (coop && ph + 1 < ph_hi) {
      if (coop == 2) cg::this_grid().sync();
      else xcd_barrier(xb);
    }
  }
}

__global__ void __launch_bounds__(512) dbg_kernel(Params p, int which) { dbg_dump(p, which); }

#ifndef MULTI_LAUNCH
#define MULTI_LAUNCH 0
#endif

extern "C" void kernel_launch(void* const* d_in, const int* in_sizes, int n_in, void* d_out, int out_size, void* d_ws, size_t ws_size,
                              hipStream_t stream) {
  static int grid_blocks = 0;
  if (!grid_blocks) {
    if (ws_size < WS_END) { fprintf(stderr, "kernel_launch: workspace too small: %zu < %zu\n", ws_size, (size_t)WS_END); return; }
    if (hipFuncSetAttribute((const void*)mega, hipFuncAttributeMaxDynamicSharedMemorySize, SMEM_BYTES) != hipSuccess) {
      fprintf(stderr, "kernel_launch: hipFuncSetAttribute failed\n"); return; }
    int dev = 0, cus = 0, per_cu = 0;
    hipGetDevice(&dev);
    hipDeviceGetAttribute(&cus, hipDeviceAttributeMultiprocessorCount, dev);
    hipOccupancyMaxActiveBlocksPerMultiprocessor(&per_cu, mega, 512, SMEM_BYTES);
    if (per_cu < 1) per_cu = 1;
    grid_blocks = 256;
    if (cus < 256) { fprintf(stderr, "kernel_launch: needs 256 CUs, have %d\n", cus); grid_blocks = 0; return; }
  }
  Params p{};
  p.x = (const float*)d_in[0]; p.c = (const float*)d_in[1]; p.ctx = (const float*)d_in[2]; p.c_ctx = (const float*)d_in[3];
  p.w_ada = (const float*)d_in[4]; p.b_ada = (const float*)d_in[5]; p.g_pre = (const float*)d_in[6]; p.g_post = (const float*)d_in[7];
  p.w_in = (const float*)d_in[8]; p.conv_w = (const float*)d_in[9]; p.q_g = (const float*)d_in[10]; p.k_g = (const float*)d_in[11];
  p.w_df = (const float*)d_in[12]; p.b_df = (const float*)d_in[13]; p.w_db = (const float*)d_in[14]; p.b_db = (const float*)d_in[15];
  p.gla_g = (const float*)d_in[16]; p.w_bc = (const float*)d_in[17]; p.w_ba = (const float*)d_in[18]; p.w_bg = (const float*)d_in[19];
  p.b_gate = (const float*)d_in[20]; p.w_out = (const float*)d_in[21];
  p.out = (float*)d_out; p.ws = (char*)d_ws;
#if MULTI_LAUNCH
  for (int ph = 0; ph < (DBG_STOP ? DBG_STOP : NPHASE); ++ph) {
    hipLaunchKernelGGL(mega, dim3(grid_blocks), dim3(512), SMEM_BYTES, stream, p, ph, ph + 1, 0);
  }
  if (DBG_STOP) hipLaunchKernelGGL(dbg_kernel, dim3(grid_blocks), dim3(512), 0, stream, p, DBG_WHICH);
#else
  hipMemsetAsync((char*)d_ws + WS_BAR, 0, 16384, stream);
  int lo = 0, hi = NPHASE, coop = 1;
  void* args[] = {&p, &lo, &hi, &coop};
  hipError_t e = hipLaunchCooperativeKernel((void*)mega, dim3(grid_blocks), dim3(512), args, SMEM_BYTES, stream);
  if (e != hipSuccess) fprintf(stderr, "cooperative launch failed: %s (grid %d)\n", hipGetErrorString(e), grid_blocks);
#endif
}
```
